# Optimizing an MI355X kernel written in HIP

```python
import jax, jax.numpy as jnp
from jax import lax
import numpy as np

D_MODEL = 1024
BATCH = 16
SEQ = 2048
DEPTH = 1

CHUNK = 64
D_MIX = D_MODEL
DN_HEADS = 4
DN_HEAD_DIM = 128
DN_WIDTH = DN_HEADS * DN_HEAD_DIM
SHORT_CONV = 4
POOL_WIDTH = D_MIX - DN_WIDTH
POOL_WINDOWS = (2, 4, 8, 16)
POOL_GROUPS = len(POOL_WINDOWS)
POOL_GROUP_DIM = POOL_WIDTH // POOL_GROUPS
D_FF = ((8 * D_MODEL // 3) + 127) // 128 * 128
FFN_CONV = 3
EPS = 1e-6
IN_COLS = 4 * DN_WIDTH + 2 * DN_HEADS + POOL_WIDTH

kernel_name = 'hybrid_deltanet_multipool_convffn'


def rmsnorm(x, w):
    xf = x.astype(jnp.float32)
    y = xf * lax.rsqrt(jnp.mean(xf * xf, axis=-1, keepdims=True) + EPS)
    return (y * w.astype(jnp.float32)).astype(x.dtype)


def l2norm(x):
    return x * lax.rsqrt(jnp.sum(x * x, axis=-1, keepdims=True) + EPS)


def causal_dwconv(x, w):
    k_width = w.shape[0]
    t_len = x.shape[1]
    xp = jnp.pad(x, ((0, 0), (k_width - 1, 0), (0, 0)))
    y = xp[:, 0:t_len] * w[0]
    for i in range(1, k_width):
        y = y + xp[:, i:i + t_len] * w[i]
    return y


def chunk_gated_delta_rule(q, k, v, g, beta):
    bsz, t_len, n_h, d_k = q.shape
    d_v = v.shape[-1]
    n_c = t_len // CHUNK

    def to_chunks(t):
        t = t.reshape((bsz, n_c, CHUNK, n_h) + t.shape[3:])
        return jnp.moveaxis(t, 3, 1)

    q, k, v, g, beta = (to_chunks(t) for t in (q, k, v, g, beta))
    G = jnp.cumsum(g, axis=-1)
    idx = jnp.arange(CHUNK)
    incl = idx[:, None] >= idx[None, :]
    strict = idx[:, None] > idx[None, :]
    diff = G[..., :, None] - G[..., None, :]
    gamma = jnp.exp(jnp.where(incl, diff, -jnp.inf))
    kk = jnp.einsum('bhnid,bhnjd->bhnij', k, k)
    a_mat = jnp.where(strict, kk * beta[..., :, None] * gamma, 0.0) + jnp.eye(CHUNK, dtype=q.dtype)
    eg = jnp.exp(G)
    rhs = jnp.concatenate([v * beta[..., None], k * (beta * eg)[..., None]], axis=-1)
    sol = lax.linalg.triangular_solve(a_mat, rhs, left_side=True, lower=True, unit_diagonal=True)
    u, w = sol[..., :d_v], sol[..., d_v:]
    qg = q * eg[..., None]
    aqk = jnp.einsum('bhnid,bhnjd->bhnij', q, k) * gamma
    kd = k * jnp.exp(G[..., -1:] - G)[..., None]
    glast = jnp.exp(G[..., -1])
    xs = tuple(jnp.moveaxis(t, 2, 0) for t in (u, w, qg, aqk, kd, glast))

    def step(S, inp):
        u_c, w_c, qg_c, aqk_c, kd_c, gl_c = inp
        v_new = u_c - jnp.einsum('bhck,bhkv->bhcv', w_c, S)
        o_c = jnp.einsum('bhck,bhkv->bhcv', qg_c, S) + jnp.einsum('bhij,bhjv->bhiv', aqk_c, v_new)
        S = S * gl_c[..., None, None] + jnp.einsum('bhck,bhcv->bhkv', kd_c, v_new)
        return S, o_c

    S0 = jnp.zeros((bsz, n_h, d_k, d_v), jnp.float32)
    _, o = lax.scan(step, S0, xs)
    return o.transpose(1, 0, 3, 2, 4).reshape(bsz, t_len, n_h, d_v)


def gated_deltanet(qkv_raw, z, b_raw, a_raw, conv_w, a_log, dt_bias, onorm_w):
    bsz, t_len, _ = qkv_raw.shape
    qkv = jax.nn.silu(causal_dwconv(qkv_raw, conv_w)).astype(jnp.float32)
    q, k, v = jnp.split(qkv, 3, axis=-1)
    heads = lambda t: t.reshape(bsz, t_len, DN_HEADS, DN_HEAD_DIM)
    q = l2norm(heads(q)) * (DN_HEAD_DIM ** -0.5)
    k = l2norm(heads(k))
    v = heads(v)
    beta = jax.nn.sigmoid(b_raw.astype(jnp.float32))
    g = -jnp.exp(a_log.astype(jnp.float32)) * jax.nn.softplus(
        a_raw.astype(jnp.float32) + dt_bias.astype(jnp.float32))
    o = chunk_gated_delta_rule(q, k, v, g, beta)
    o = rmsnorm(o, onorm_w) * jax.nn.silu(heads(z).astype(jnp.float32))
    return o.reshape(bsz, t_len, DN_WIDTH).astype(qkv_raw.dtype)


def multiscale_pool(u, pool_w, pool_b, pool_scale):
    bsz, t_len, _ = u.shape
    ug = u.astype(jnp.float32).reshape(bsz, t_len, POOL_GROUPS, POOL_GROUP_DIM)
    cs = jnp.cumsum(ug, axis=1)
    pos = jnp.arange(1, t_len + 1, dtype=jnp.float32)
    pooled = []
    for gi, win in enumerate(POOL_WINDOWS):
        c = cs[:, :, gi]
        lagged = jnp.pad(c, ((0, 0), (win, 0), (0, 0)))[:, :t_len]
        cnt = jnp.minimum(pos, float(win))[None, :, None]
        pooled.append((c - lagged) / cnt)
    d = jnp.stack(pooled, axis=2) - ug
    y = jnp.einsum('btgc,gcd->btgd', d, pool_w.astype(jnp.float32)) + pool_b.astype(jnp.float32)
    return (y.reshape(bsz, t_len, POOL_WIDTH) * pool_scale.astype(jnp.float32)).astype(u.dtype)


def setup_inputs(seed: int = 0) -> dict:
    key = jax.random.key(seed)
    ks = jax.random.split(key, 20)
    f32 = jnp.float32
    nrm = lambda k, shape, scale: jax.random.normal(k, shape, f32) * scale
    x = jax.random.normal(ks[0], (BATCH, SEQ, D_MODEL), f32)
    norm1_w = 1.0 + nrm(ks[1], (DEPTH, D_MODEL), 0.02)
    w_in = nrm(ks[2], (DEPTH, D_MODEL, IN_COLS), D_MODEL ** -0.5)
    conv_qkv_w = nrm(ks[3], (DEPTH, SHORT_CONV, 3 * DN_WIDTH), SHORT_CONV ** -0.5)
    a_log = jnp.log(jax.random.uniform(ks[4], (DEPTH, DN_HEADS), f32, 1.0, 16.0))
    dt = jnp.exp(jax.random.uniform(ks[5], (DEPTH, DN_HEADS), f32, math_log(1e-3), math_log(0.1)))
    dt_bias = dt + jnp.log(-jnp.expm1(-dt))
    onorm_w = 1.0 + nrm(ks[6], (DEPTH, DN_HEAD_DIM), 0.02)
    pool_w = nrm(ks[7], (DEPTH, POOL_GROUPS, POOL_GROUP_DIM, POOL_GROUP_DIM), POOL_GROUP_DIM ** -0.5)
    pool_b = nrm(ks[8], (DEPTH, POOL_GROUPS, POOL_GROUP_DIM), 0.01)
    pool_scale = 1.0 + nrm(ks[9], (DEPTH, POOL_WIDTH), 0.02)
    w_out = nrm(ks[10], (DEPTH, D_MIX, D_MODEL), D_MIX ** -0.5)
    norm2_w = 1.0 + nrm(ks[11], (DEPTH, D_MODEL), 0.02)
    w_up = nrm(ks[12], (DEPTH, D_MODEL, 2 * D_FF), D_MODEL ** -0.5)
    ffn_conv_w = nrm(ks[13], (DEPTH, FFN_CONV, 2 * D_FF), FFN_CONV ** -0.5)
    ffn_conv_b = nrm(ks[14], (DEPTH, 2 * D_FF), 0.01)
    w_down = nrm(ks[15], (DEPTH, D_FF, D_MODEL), D_FF ** -0.5)
    final_norm_w = 1.0 + nrm(ks[16], (D_MODEL,), 0.02)
    return {'x': x, 'norm1_w': norm1_w, 'w_in': w_in, 'conv_qkv_w': conv_qkv_w,
            'a_log': a_log, 'dt_bias': dt_bias, 'onorm_w': onorm_w, 'pool_w': pool_w,
            'pool_b': pool_b, 'pool_scale': pool_scale, 'w_out': w_out, 'norm2_w': norm2_w,
            'w_up': w_up, 'ffn_conv_w': ffn_conv_w, 'ffn_conv_b': ffn_conv_b,
            'w_down': w_down, 'final_norm_w': final_norm_w}


def math_log(v):
    return float(np.log(v))


def reference(x, norm1_w, w_in, conv_qkv_w, a_log, dt_bias, onorm_w, pool_w, pool_b,
              pool_scale, w_out, norm2_w, w_up, ffn_conv_w, ffn_conv_b, w_down, final_norm_w):
    c_q = 3 * DN_WIDTH
    c_z = 4 * DN_WIDTH
    c_b = c_z + DN_HEADS
    c_a = c_b + DN_HEADS
    for l in range(DEPTH):
        h = rmsnorm(x, norm1_w[l])
        proj = h @ w_in[l]
        o_a = gated_deltanet(proj[..., :c_q], proj[..., c_q:c_z], proj[..., c_z:c_b],
                             proj[..., c_b:c_a], conv_qkv_w[l], a_log[l], dt_bias[l], onorm_w[l])
        o_b = multiscale_pool(proj[..., c_a:], pool_w[l], pool_b[l], pool_scale[l])
        x = x + jnp.concatenate([o_a, o_b], axis=-1) @ w_out[l]
        h = rmsnorm(x, norm2_w[l])
        up = causal_dwconv(h @ w_up[l], ffn_conv_w[l]) + ffn_conv_b[l]
        gate, val = jnp.split(up, 2, axis=-1)
        x = x + (jax.nn.silu(gate) * val) @ w_down[l]
    return rmsnorm(x, final_norm_w)
```

```cpp
#include <hip/hip_runtime.h>
#include <hip/hip_cooperative_groups.h>
#include <cstdio>
namespace cg = cooperative_groups;
namespace pg8 {
#define PG8_LAS __attribute__((address_space(3)))
typedef unsigned short bf16_t;
typedef short bf16x8 __attribute__((ext_vector_type(8)));
typedef float f32x4 __attribute__((ext_vector_type(4)));
typedef unsigned u32x4 __attribute__((ext_vector_type(4)));
constexpr int BM = 256, BK = 64, HALF = 128, HTB = HALF * BK * 2  , STAGE_BYTES = 8 * HTB, NXCD = 8, WGM = 8;

__host__ __device__ __forceinline__ int lds_byte(int r, int c) { const int st = (r >> 4) * 2 + (c >> 5), rr = r & 15, cc = c & 31, ob = rr * 64 + cc * 2; return st * 1024 + (ob ^ (((ob >> 9) & 1) << 5)); }
__host__ __device__ __forceinline__ void stage_rc(int b, int& R, int& C) { const int st = b / 1024, sb = b % 1024, swz = sb ^ (((sb >> 9) & 1) << 5); R = (st >> 1) * 16 + swz / 64; C = (st & 1) * 32 + (swz % 64) / 2; }
__host__ __device__ __forceinline__ int perm32(int rho) { const int n = rho >> 4, i = rho & 15; return 8 * (i >> 2) + 4 * n + (i & 3); }

struct Unit { int pm, pn; };
struct Gemm { const bf16_t* A; const bf16_t* Bt; int M, N, K; };
struct StaticOrder {
    int nM, nN, nwg, G, c;
    __host__ __device__ void init(int M, int N, int G_, int c_) { nM = M / BM; nN = N / BM; nwg = nM * nN; G = G_; c = c_; }
    __host__ __device__ bool next(int i, Unit& u) const {
        const long L = (long)i * G + c; if (L >= nwg) return false;
        int wgid = (int)L; { const int q = nwg / NXCD, r = nwg % NXCD, xcd = wgid % NXCD, off = wgid / NXCD; wgid = (xcd < r ? xcd * (q + 1) : r * (q + 1) + (xcd - r) * q) + off; }
        const int nig = WGM * nN, gid = wgid / nig, fm = gid * WGM, gsz = (nM - fm) < WGM ? (nM - fm) : WGM;
        u.pm = fm + ((wgid % nig) % gsz); u.pn = (wgid % nig) / gsz; return true;
    }
    __device__ __forceinline__ void a_ready(const Unit&) const {}
    __device__ __forceinline__ void done(const Unit&) const {}
};
__device__ __forceinline__ unsigned cvt_pk_bf16(float lo, float hi) { unsigned r; asm volatile("v_cvt_pk_bf16_f32 %0, %1, %2" : "=v"(r) : "v"(lo), "v"(hi)); return r; }
template <class Epi, class Sched, bool ALIGN_EPI = false, bool SP2 = false>
__device__ __forceinline__ void gemm_phase(PG8_LAS unsigned char* lds, const Gemm g, const Sched& S, const Epi& E) {
    const int tid = threadIdx.x, wid = __builtin_amdgcn_readfirstlane(tid >> 6), lane = tid & 63, wr = wid >> 2, wc = wid & 3, fr = lane & 15, fq = lane >> 4;
    const int K = g.K, nt = K / BK;
    unsigned voffA[2], voffB[2];
#pragma unroll
    for (int i = 0; i < 2; ++i) { int R, C; stage_rc(tid * 16 + i * 8192, R, C); const int Rb = Epi::PERM ? ((R & ~31) + perm32(R & 31)) : R;
        const int Ra = Epi::PERMA ? ((R & 64) + 4 * (R & 15) + ((R >> 4) & 3)) : R; voffA[i] = (unsigned)(Ra * K + C) * 2u; voffB[i] = (unsigned)(Rb * K + C) * 2u; }
    const size_t kstep = (size_t)(BK * 2);
    const size_t hstep = (size_t)HALF * K * 2;
    const size_t tstep = 2 * hstep;
    const unsigned ldsw = (unsigned)wid * 1024u;
    const int aoff = lds_byte(wr * 64 + fr, fq * 8), boff = lds_byte(wc * 32 + fr, fq * 8);
#define PG8_SA(b, h) (((b) * 2 + (h)) * HTB)
#define PG8_SB(b, h) ((4 + (b) * 2 + (h)) * HTB)
#define PG8_STAGE(bufoff, gbase, voff) do { _Pragma("unroll") for (int _i = 0; _i < 2; ++_i) \
        __builtin_amdgcn_global_load_lds((const unsigned*)((const char*)(gbase) + (voff)[_i]), (PG8_LAS unsigned*)(lds + (bufoff) + ldsw + _i * 8192), 16, 0, 0); } while (0)
#define PG8_LDA(dst, b, h) do { _Pragma("unroll") for (int m = 0; m < 4; ++m) _Pragma("unroll") for (int k = 0; k < 2; ++k) dst[m][k] = *(const PG8_LAS bf16x8*)(lds + PG8_SA(b, h) + aoff + m * 2048 + k * 1024); } while (0)
#define PG8_LDB(dst, b, h) do { _Pragma("unroll") for (int n = 0; n < 2; ++n) _Pragma("unroll") for (int k = 0; k < 2; ++k) dst[n][k] = *(const PG8_LAS bf16x8*)(lds + PG8_SB(b, h) + boff + n * 2048 + k * 1024); } while (0)
#define PG8_MMA(ai, bj, At, Bt) do { __builtin_amdgcn_s_setprio(1); _Pragma("unroll") for (int m = 0; m < 4; ++m) _Pragma("unroll") for (int n = 0; n < 2; ++n) _Pragma("unroll") for (int k = 0; k < 2; ++k) \
        acc[ai][bj][m][n] = __builtin_amdgcn_mfma_f32_16x16x32_bf16(Bt[n][k], At[m][k], acc[ai][bj][m][n], 0, 0, 0); __builtin_amdgcn_s_setprio(0); } while (0)
#define PG8_WAIT_V(n) asm volatile("s_waitcnt vmcnt(" #n ")" ::: "memory")
#define PG8_WAIT_L(n) asm volatile("s_waitcnt lgkmcnt(" #n ")" ::: "memory")
#define PG8_BAR __builtin_amdgcn_s_barrier()
#define PG8_SCHED __builtin_amdgcn_sched_barrier(0)
    Unit cur, nxt; int ui = 0;
    if (!S.next(0, cur)) return;
    f32x4 acc[2][2][4][2];
#pragma unroll
    for (int a = 0; a < 2; ++a)
#pragma unroll
        for (int b = 0; b < 2; ++b)
#pragma unroll
            for (int m = 0; m < 4; ++m)
#pragma unroll
                for (int n = 0; n < 2; ++n) acc[a][b][m][n] = (f32x4){0.f, 0.f, 0.f, 0.f};
    bf16x8 At[4][2], B0[2][2], B1[2][2];
    const char* cA = (const char*)g.A + (size_t)cur.pm * tstep; const char* cB = (const char*)g.Bt + (size_t)cur.pn * tstep;
    S.a_ready(cur);
    if constexpr (SP2) {
        PG8_STAGE(PG8_SB(0, 0), cB, voffB); PG8_STAGE(PG8_SB(0, 1), cB + hstep, voffB); PG8_STAGE(PG8_SA(0, 0), cA, voffA); PG8_STAGE(PG8_SA(0, 1), cA + hstep, voffA);
        if (wr == 1) PG8_BAR;
        PG8_WAIT_V(2); PG8_BAR;
        PG8_STAGE(PG8_SB(1, 0), cB + kstep, voffB); PG8_STAGE(PG8_SA(1, 0), cA + kstep, voffA); PG8_STAGE(PG8_SB(1, 1), cB + hstep + kstep, voffB);
        PG8_WAIT_V(6); PG8_BAR;
    } else {
        PG8_STAGE(PG8_SB(0, 0), cB, voffB); PG8_STAGE(PG8_SA(0, 0), cA, voffA); PG8_STAGE(PG8_SB(0, 1), cB + hstep, voffB); PG8_STAGE(PG8_SA(0, 1), cA + hstep, voffA);
        if (wr == 1) PG8_BAR;
        PG8_WAIT_V(4); PG8_BAR;
        PG8_STAGE(PG8_SB(1, 0), cB + kstep, voffB); PG8_STAGE(PG8_SA(1, 0), cA + kstep, voffA); PG8_STAGE(PG8_SB(1, 1), cB + hstep + kstep, voffB);
        PG8_WAIT_V(6); PG8_BAR;
    }
    for (;;) {
        const bool has_next = S.next(ui + 1, nxt);
        const char* nA = has_next ? (const char*)g.A + (size_t)nxt.pm * tstep : cA; const char* nB = has_next ? (const char*)g.Bt + (size_t)nxt.pn * tstep : cB;
        for (int t = 0; t < nt; t += 2) {
            const bool last = (t == nt - 2);
            const char* a1 = cA + (size_t)(t + 1) * kstep;
            const char* a2 = last ? nA : cA + (size_t)(t + 2) * kstep; const char* b2 = last ? nB : cB + (size_t)(t + 2) * kstep;
            const char* a3 = a2 + kstep; const char* b3 = b2 + kstep;
            if (last && has_next) S.a_ready(nxt);
            if constexpr (SP2) {
            PG8_LDB(B0, 0, 0); PG8_LDB(B1, 0, 1); PG8_SCHED; PG8_LDA(At, 0, 0); PG8_STAGE(PG8_SA(1, 1), a1 + hstep, voffA);
            PG8_WAIT_V(8); PG8_WAIT_L(0); PG8_BAR; PG8_MMA(0, 0, At, B0); PG8_MMA(0, 1, At, B1); PG8_BAR; PG8_SCHED;
            PG8_LDA(At, 0, 1); PG8_STAGE(PG8_SB(0, 0), b2, voffB); PG8_STAGE(PG8_SB(0, 1), b2 + hstep, voffB); PG8_STAGE(PG8_SA(0, 0), a2, voffA);
            PG8_WAIT_V(8); PG8_WAIT_L(0); PG8_BAR; PG8_MMA(1, 0, At, B0); PG8_MMA(1, 1, At, B1); PG8_BAR; PG8_SCHED;
            PG8_LDB(B0, 1, 0); PG8_LDB(B1, 1, 1); PG8_SCHED; PG8_LDA(At, 1, 0); PG8_STAGE(PG8_SA(0, 1), a2 + hstep, voffA);
            PG8_WAIT_V(8); PG8_WAIT_L(0); PG8_BAR; PG8_MMA(0, 0, At, B0); PG8_MMA(0, 1, At, B1); PG8_BAR; PG8_SCHED;
            PG8_LDA(At, 1, 1); PG8_STAGE(PG8_SB(1, 0), b3, voffB); PG8_STAGE(PG8_SB(1, 1), b3 + hstep, voffB); PG8_STAGE(PG8_SA(1, 0), a3, voffA);
            PG8_WAIT_V(8); PG8_WAIT_L(0); PG8_BAR; PG8_MMA(1, 0, At, B0); PG8_MMA(1, 1, At, B1); PG8_BAR; PG8_SCHED;
            } else {
            PG8_LDB(B0, 0, 0); PG8_SCHED; PG8_LDA(At, 0, 0); PG8_STAGE(PG8_SA(1, 1), a1 + hstep, voffA);
            PG8_WAIT_L(8); PG8_BAR; PG8_WAIT_L(0); PG8_MMA(0, 0, At, B0); PG8_BAR; PG8_SCHED;
            PG8_LDB(B1, 0, 1); PG8_STAGE(PG8_SB(0, 0), b2, voffB);
            PG8_BAR; PG8_WAIT_L(0); PG8_MMA(0, 1, At, B1); PG8_BAR;
            PG8_LDA(At, 0, 1); PG8_STAGE(PG8_SA(0, 0), a2, voffA);
            PG8_BAR; PG8_WAIT_L(0); PG8_MMA(1, 0, At, B0); PG8_BAR; PG8_SCHED;
            PG8_STAGE(PG8_SB(0, 1), b2 + hstep, voffB);
            PG8_WAIT_V(6); PG8_BAR; PG8_MMA(1, 1, At, B1); PG8_BAR;
            PG8_LDB(B0, 1, 0); PG8_SCHED; PG8_LDA(At, 1, 0); PG8_STAGE(PG8_SA(0, 1), a2 + hstep, voffA);
            PG8_WAIT_L(8); PG8_BAR; PG8_WAIT_L(0); PG8_MMA(0, 0, At, B0); PG8_BAR; PG8_SCHED;
            PG8_LDB(B1, 1, 1); PG8_STAGE(PG8_SB(1, 0), b3, voffB);
            PG8_BAR; PG8_WAIT_L(0); PG8_MMA(0, 1, At, B1); PG8_BAR;
            PG8_LDA(At, 1, 1); PG8_STAGE(PG8_SA(1, 0), a3, voffA);
            PG8_BAR; PG8_WAIT_L(0); PG8_MMA(1, 0, At, B0); PG8_BAR; PG8_SCHED;
            PG8_STAGE(PG8_SB(1, 1), b3 + hstep, voffB);
            PG8_WAIT_V(6); PG8_BAR; PG8_MMA(1, 1, At, B1); PG8_BAR;
            }
        }
        if constexpr (ALIGN_EPI) { if (wr == 0) PG8_BAR; }
        if constexpr (!Epi::AFTER_DRAIN) { E(acc, cur, wr, wc, fr, fq); S.done(cur); }
        if (!has_next) break;
#pragma unroll
        for (int a = 0; a < 2; ++a)
#pragma unroll
            for (int b = 0; b < 2; ++b)
#pragma unroll
                for (int m = 0; m < 4; ++m)
#pragma unroll
                    for (int n = 0; n < 2; ++n) acc[a][b][m][n] = (f32x4){0.f, 0.f, 0.f, 0.f};
        cur = nxt; cA = nA; cB = nB; ++ui;
        if constexpr (ALIGN_EPI) { if (wr == 1) PG8_BAR; }
    }
    PG8_WAIT_V(0);
    if constexpr (!ALIGN_EPI) { if (wr == 0) PG8_BAR; }
    PG8_BAR;
    if constexpr (Epi::AFTER_DRAIN) { E.fused(acc, cur, wr, wc, fr, fq, lds, wid, lane); S.done(cur); }
#undef PG8_SA
#undef PG8_SB
#undef PG8_STAGE
#undef PG8_LDA
#undef PG8_LDB
#undef PG8_MMA
#undef PG8_WAIT_V
#undef PG8_WAIT_L
#undef PG8_BAR
#undef PG8_SCHED
}
}

typedef pg8::bf16_t bf16_t;
typedef pg8::f32x4 f32x4;
typedef pg8::u32x4 u32x4;
typedef unsigned u32x2 __attribute__((ext_vector_type(2)));

constexpr int M = 32768, D = 1024, NPROJ = 2560, DFF = 2816, NUP = 5632;
constexpr float EPS = 1e-6f;
constexpr size_t MBY = 1048576;
constexpr size_t WS_WIN = 0, WS_WOUT = 5 * MBY, WS_WUP = 7 * MBY, WS_WDOWN = 18 * MBY, WS_BETA = 24 * MBY, WS_G = 24 * MBY + MBY / 2, WS_SS2 = 25 * MBY;
constexpr size_t WS_H1B = 32 * MBY, WS_MIX = 32 * MBY, WS_PROJ = 96 * MBY, WS_QB = 256 * MBY, WS_KB = 288 * MBY, WS_VB = 320 * MBY, WS_OF = 352 * MBY;
constexpr size_t WS_XB = 96 * MBY, WS_UPH = 160 * MBY, WS_ACT = 336 * MBY, WS_END = 512 * MBY;
constexpr size_t WS_KT = 32 * MBY, WS_VT = 64 * MBY, WS_RS1 = 27 * MBY + 262144;
constexpr int LDS_BYTES = 131072 + 256 + 8192, NT = 512;
constexpr size_t WS_BAR = 30 * MBY;

struct Args { const float* in[17]; float* out; unsigned char* ws; unsigned mask; unsigned pad; };

__device__ __forceinline__ float bf_lo(unsigned w) { return __uint_as_float(w << 16); }
__device__ __forceinline__ float bf_hi(unsigned w) { return __uint_as_float(w & 0xffff0000u); }
typedef float f32x2_ __attribute__((ext_vector_type(2)));
typedef __bf16 bf16x2_ __attribute__((ext_vector_type(2)));
__device__ __forceinline__ unsigned pk2(float a, float b) { return pg8::cvt_pk_bf16(a, b); }
__device__ __forceinline__ unsigned pk2c(float a, float b) { const f32x2_ v = {a, b}; const bf16x2_ r = __builtin_convertvector(v, bf16x2_); return __builtin_bit_cast(unsigned, r); }
__device__ __forceinline__ void unpack8(const u32x4 w, float (&f)[8]) { f[0] = bf_lo(w.x); f[1] = bf_hi(w.x); f[2] = bf_lo(w.y); f[3] = bf_hi(w.y); f[4] = bf_lo(w.z); f[5] = bf_hi(w.z); f[6] = bf_lo(w.w); f[7] = bf_hi(w.w); }
__device__ __forceinline__ u32x4 pack8(const float (&f)[8]) { u32x4 o; o.x = pk2(f[0], f[1]); o.y = pk2(f[2], f[3]); o.z = pk2(f[4], f[5]); o.w = pk2(f[6], f[7]); return o; }
__device__ __forceinline__ float wave_sum(float v) {
#pragma unroll
    for (int o = 1; o < 64; o <<= 1) v += __shfl_xor(v, o);
    return v;
}
template <int CTRL> __device__ __forceinline__ float dpp_mov(float x) { return __builtin_bit_cast(float, __builtin_amdgcn_update_dpp(0, __builtin_bit_cast(int, x), CTRL, 0xf, 0xf, true)); }
__device__ __forceinline__ float sum16(float v) {
    v += dpp_mov<0x128>(v); v += dpp_mov<0x124>(v); v += dpp_mov<0x122>(v); v += dpp_mov<0x121>(v);
    return v;
}
__device__ __forceinline__ float row_up1(float v) { return dpp_mov<0x111>(v); }
__device__ __forceinline__ float sigmoidf_(float x) { return __builtin_amdgcn_rcpf(1.0f + __builtin_amdgcn_exp2f(x * -1.4426950408889634f)); }
__device__ __forceinline__ float siluf_(float x) { return x * __builtin_amdgcn_rcpf(1.0f + __builtin_amdgcn_exp2f(x * -1.4426950408889634f)); }

struct EpiBf16Plain {
    static constexpr bool PERM = true, PERMA = false, AFTER_DRAIN = false;
    bf16_t* O; int ldc; const float* RS;
    __device__ __forceinline__ void operator()(const f32x4 (&acc)[2][2][4][2], const pg8::Unit& u, int wr, int wc, int fr, int fq) const {
        const int row0 = u.pm * 256 + wr * 64 + fr, col0 = u.pn * 256 + wc * 32 + 8 * fq;
        float rs[2][4];
#pragma unroll
        for (int ai = 0; ai < 2; ++ai)
#pragma unroll
            for (int m = 0; m < 4; ++m) rs[ai][m] = RS[row0 + ai * 128 + m * 16];
#pragma unroll
        for (int ai = 0; ai < 2; ++ai)
#pragma unroll
            for (int m = 0; m < 4; ++m) { bf16_t* rowp = O + (size_t)(row0 + ai * 128 + m * 16) * ldc + col0;
#pragma unroll
                for (int bj = 0; bj < 2; ++bj) { const f32x4 v0 = acc[ai][bj][m][0] * rs[ai][m], v1 = acc[ai][bj][m][1] * rs[ai][m];
                    u32x4 w; w.x = pk2(v0[0], v0[1]); w.y = pk2(v0[2], v0[3]); w.z = pk2(v1[0], v1[1]); w.w = pk2(v1[2], v1[3]);
                    *(u32x4*)(rowp + bj * 128) = w; } }
    }
};
struct EpiOutProj {
    static constexpr bool PERM = true, PERMA = false, AFTER_DRAIN = false;
    const bf16_t* X; bf16_t* XB; float* SS;
    __device__ __forceinline__ void operator()(f32x4 (&acc)[2][2][4][2], const pg8::Unit& u, int wr, int wc, int fr, int fq) const {
        const int row0 = u.pm * 256 + wr * 64 + fr, col0 = u.pn * 256 + wc * 32 + 8 * fq;
#pragma unroll
        for (int ai = 0; ai < 2; ++ai) {
            f32x4 rx[4][2][2];
#pragma unroll
            for (int m = 0; m < 4; ++m)
#pragma unroll
                for (int bj = 0; bj < 2; ++bj) { float f[8]; unpack8(*(const u32x4*)(X + (size_t)(row0 + ai * 128 + m * 16) * 1024 + col0 + bj * 128), f);
                    rx[m][bj][0] = (f32x4){f[0], f[1], f[2], f[3]}; rx[m][bj][1] = (f32x4){f[4], f[5], f[6], f[7]}; }
#pragma unroll
            for (int m = 0; m < 4; ++m) { const int row = row0 + ai * 128 + m * 16; float s = 0.f;
#pragma unroll
                for (int bj = 0; bj < 2; ++bj) { const f32x4 v0 = acc[ai][bj][m][0] + rx[m][bj][0], v1 = acc[ai][bj][m][1] + rx[m][bj][1];
                    s += (v0[0] * v0[0] + v0[1] * v0[1]) + (v0[2] * v0[2] + v0[3] * v0[3]) + (v1[0] * v1[0] + v1[1] * v1[1]) + (v1[2] * v1[2] + v1[3] * v1[3]);
                    u32x4 w; w.x = pk2(v0[0], v0[1]); w.y = pk2(v0[2], v0[3]); w.z = pk2(v1[0], v1[1]); w.w = pk2(v1[2], v1[3]);
                    *(u32x4*)(XB + (size_t)row * 1024 + col0 + bj * 128) = w; }
                s += __shfl_xor(s, 16); s += __shfl_xor(s, 32); if (fq == 0) SS[(size_t)row * 16 + u.pn * 4 + wc] = s; }
        }
    }
};
constexpr size_t WS_YB = 192 * MBY, WS_SS3 = 25 * MBY;
struct EpiDown {
    static constexpr bool PERM = true, PERMA = false, AFTER_DRAIN = false;
    const bf16_t* XB; bf16_t* YB; float* SS;
    __device__ __forceinline__ void operator()(f32x4 (&acc)[2][2][4][2], const pg8::Unit& u, int wr, int wc, int fr, int fq) const {
        const int row0 = u.pm * 256 + wr * 64 + fr, col0 = u.pn * 256 + wc * 32 + 8 * fq;
#pragma unroll
        for (int ai = 0; ai < 2; ++ai) {
            u32x4 rx[4][2];
#pragma unroll
            for (int m = 0; m < 4; ++m)
#pragma unroll
                for (int bj = 0; bj < 2; ++bj) rx[m][bj] = *(const u32x4*)(XB + (size_t)(row0 + ai * 128 + m * 16) * 1024 + col0 + bj * 128);
#pragma unroll
            for (int m = 0; m < 4; ++m) { const int row = row0 + ai * 128 + m * 16; float s = 0.f;
#pragma unroll
                for (int bj = 0; bj < 2; ++bj) { float f[8]; unpack8(rx[m][bj], f);
                    const f32x4 v0 = acc[ai][bj][m][0] + (f32x4){f[0], f[1], f[2], f[3]}, v1 = acc[ai][bj][m][1] + (f32x4){f[4], f[5], f[6], f[7]};
                    s += (v0[0] * v0[0] + v0[1] * v0[1]) + (v0[2] * v0[2] + v0[3] * v0[3]) + (v1[0] * v1[0] + v1[1] * v1[1]) + (v1[2] * v1[2] + v1[3] * v1[3]);
                    u32x4 w; w.x = pk2(v0[0], v0[1]); w.y = pk2(v0[2], v0[3]); w.z = pk2(v1[0], v1[1]); w.w = pk2(v1[2], v1[3]);
                    *(u32x4*)(YB + (size_t)row * 1024 + col0 + bj * 128) = w; }
                s += __shfl_xor(s, 16); s += __shfl_xor(s, 32); if (fq == 0) SS[(size_t)row * 16 + u.pn * 4 + wc] = s; }
        }
    }
};
struct EpiUpRaw {
    static constexpr bool PERM = true, PERMA = false, AFTER_DRAIN = false;
    bf16_t* O; const float* SS;
    __device__ __forceinline__ void operator()(const f32x4 (&acc)[2][2][4][2], const pg8::Unit& u, int wr, int wc, int fr, int fq) const {
        const int row0 = u.pm * 256 + wr * 64 + fr, col0 = u.pn * 256 + wc * 32 + 8 * fq;
#pragma unroll
        for (int ai = 0; ai < 2; ++ai)
#pragma unroll
            for (int m = 0; m < 4; ++m) { const int row = row0 + ai * 128 + m * 16;
                const f32x4 sv = *(const f32x4*)(SS + (size_t)row * 16 + 4 * fq); float s = (sv[0] + sv[1]) + (sv[2] + sv[3]); s += __shfl_xor(s, 16); s += __shfl_xor(s, 32);
                const float rstd = rsqrtf(s * (1.0f / 1024.0f) + EPS);
                bf16_t* rowp = O + (size_t)row * NUP + col0;
#pragma unroll
                for (int bj = 0; bj < 2; ++bj) { const f32x4 v0 = acc[ai][bj][m][0] * rstd, v1 = acc[ai][bj][m][1] * rstd;
                    u32x4 w; w.x = pk2(v0[0], v0[1]); w.y = pk2(v0[2], v0[3]); w.z = pk2(v1[0], v1[1]); w.w = pk2(v1[2], v1[3]);
                    *(u32x4*)(rowp + bj * 128) = w; } }
    }
};

constexpr size_t WS_HALO = 160 * MBY, WS_PWT = 28 * MBY;
struct EpiUpFused {
    static constexpr bool PERM = true, PERMA = true, AFTER_DRAIN = false;
    bf16_t* ACT; bf16_t* HALO; const float* SS; const float* FW; const float* FB; PG8_LAS unsigned char* WL;
    __device__ __forceinline__ void operator()(f32x4 (&acc)[2][2][4][2], const pg8::Unit& u, int wr, int wc, int fr, int fq) const {
        const int colj = u.pn * 128 + wc * 32 + 8 * fq;
        PG8_LAS unsigned char* wl = WL + (wr * 4 + wc) * 1024;
        {
            const int l = fq * 16 + fr, p = l >> 4, bj = (l >> 3) & 1, c4 = (l & 7) * 4;
            const float* srcp = (p < 3 ? FW + p * NUP : FB) + bj * DFF + u.pn * 128 + wc * 32 + c4;
            *(PG8_LAS f32x4*)(wl + l * 16) = *(const f32x4*)srcp;
        }
#pragma unroll
        for (int ai = 0; ai < 2; ++ai) {
            const int tb = u.pm * 256 + ai * 128 + wr * 64 + 4 * fr;
            float rstd[4];
#pragma unroll
            for (int m = 0; m < 4; ++m) { const f32x4 sv = *(const f32x4*)(SS + (size_t)(tb + m) * 16 + 4 * fq); float s = (sv[0] + sv[1]) + (sv[2] + sv[3]); s += __shfl_xor(s, 16); s += __shfl_xor(s, 32);
                rstd[m] = rsqrtf(s * (1.0f / 1024.0f) + EPS); }
            u32x2 pk[2][4];
#pragma unroll
            for (int n = 0; n < 2; ++n) {
                f32x4 g[4];
                {   const PG8_LAS unsigned char* wq = wl + (8 * fq + 4 * n) * 4;
                    const f32x4 w0 = *(const PG8_LAS f32x4*)(wq), w1 = *(const PG8_LAS f32x4*)(wq + 256), w2 = *(const PG8_LAS f32x4*)(wq + 512), bb = *(const PG8_LAS f32x4*)(wq + 768);
                    const f32x4 x0 = acc[ai][0][0][n] * rstd[0], x1 = acc[ai][0][1][n] * rstd[1], x2 = acc[ai][0][2][n] * rstd[2], x3 = acc[ai][0][3][n] * rstd[3];
                    acc[ai][0][0][n] = x0; acc[ai][0][1][n] = x1; acc[ai][0][2][n] = x2; acc[ai][0][3][n] = x3;
                    f32x4 p1, p2;
#pragma unroll
                    for (int c = 0; c < 4; ++c) { p1[c] = row_up1(x3[c]); p2[c] = row_up1(x2[c]); }
                    g[0] = bb + w2 * x0 + w1 * p1 + w0 * p2; g[1] = bb + w2 * x1 + w1 * x0 + w0 * p1;
                    g[2] = bb + w2 * x2 + w1 * x1 + w0 * x0; g[3] = bb + w2 * x3 + w1 * x2 + w0 * x1;
#pragma unroll
                    for (int m = 0; m < 4; ++m)
#pragma unroll
                        for (int c = 0; c < 4; ++c) g[m][c] = siluf_(g[m][c]);
                }
                __builtin_amdgcn_sched_barrier(0);
                {   const PG8_LAS unsigned char* wq = wl + 128 + (8 * fq + 4 * n) * 4;
                    const f32x4 w0 = *(const PG8_LAS f32x4*)(wq), w1 = *(const PG8_LAS f32x4*)(wq + 256), w2 = *(const PG8_LAS f32x4*)(wq + 512), bb = *(const PG8_LAS f32x4*)(wq + 768);
                    const f32x4 x0 = acc[ai][1][0][n] * rstd[0], x1 = acc[ai][1][1][n] * rstd[1], x2 = acc[ai][1][2][n] * rstd[2], x3 = acc[ai][1][3][n] * rstd[3];
                    acc[ai][1][0][n] = x0; acc[ai][1][1][n] = x1; acc[ai][1][2][n] = x2; acc[ai][1][3][n] = x3;
                    f32x4 p1, p2;
#pragma unroll
                    for (int c = 0; c < 4; ++c) { p1[c] = row_up1(x3[c]); p2[c] = row_up1(x2[c]); }
                    g[0] *= bb + w2 * x0 + w1 * p1 + w0 * p2; g[1] *= bb + w2 * x1 + w1 * x0 + w0 * p1;
                    g[2] *= bb + w2 * x2 + w1 * x1 + w0 * x0; g[3] *= bb + w2 * x3 + w1 * x2 + w0 * x1;
                }
#pragma unroll
                for (int m = 0; m < 4; ++m) { pk[n][m].x = pk2(g[m][0], g[m][1]); pk[n][m].y = pk2(g[m][2], g[m][3]); }
                __builtin_amdgcn_sched_barrier(0);
            }
#pragma unroll
            for (int m = 0; m < 4; ++m) if (fr != 0 || m >= 2) {
                u32x4 w; w.x = pk[0][m].x; w.y = pk[0][m].y; w.z = pk[1][m].x; w.w = pk[1][m].y;
                *(u32x4*)(ACT + (size_t)(tb + m) * DFF + colj) = w; }
            const int seg = u.pm * 4 + ai * 2 + wr;
            if (fr == 0 || fr == 15) {
#pragma unroll
                for (int mm = 0; mm < 2; ++mm) { const int m = (fr == 0) ? mm : 2 + mm;
#pragma unroll
                    for (int bj = 0; bj < 2; ++bj) { const f32x4 v0 = (fr == 0) ? acc[ai][bj][mm][0] : acc[ai][bj][2 + mm][0], v1 = (fr == 0) ? acc[ai][bj][mm][1] : acc[ai][bj][2 + mm][1];
                        u32x4 w; w.x = pk2(v0[0], v0[1]); w.y = pk2(v0[2], v0[3]); w.z = pk2(v1[0], v1[1]); w.w = pk2(v1[2], v1[3]);
                        *(u32x4*)(HALO + ((size_t)(seg * 4 + m) * 2 + bj) * DFF + colj) = w; } }
            }
        }
    }
};
__device__ __forceinline__ void phase_fixup(const Args& a) {
    const bf16_t* halo = (const bf16_t*)(a.ws + WS_HALO); bf16_t* act = (bf16_t*)(a.ws + WS_ACT);
    const float* fw = a.in[13]; const float* fb = a.in[14];
    const int total = 512 * 2 * 352;
    for (int it = blockIdx.x * NT + threadIdx.x; it < total; it += gridDim.x * NT) {
        const int p = it % 352, rs = it / 352, rho = rs & 1, seg = rs >> 1, j0 = p * 8; const bool first = (seg & 31) == 0; const size_t t = (size_t)seg * 64 + rho;
        float o[2][8];
#pragma unroll
        for (int bj = 0; bj < 2; ++bj) { const int col = bj * DFF + j0;
            float cur[8], m1[8], m2[8];
            unpack8(*(const u32x4*)(halo + ((size_t)(seg * 4 + rho) * 2 + bj) * DFF + j0), cur);
#pragma unroll
            for (int e = 0; e < 8; ++e) { m1[e] = 0.f; m2[e] = 0.f; }
            if (rho == 1) { unpack8(*(const u32x4*)(halo + ((size_t)(seg * 4 + 0) * 2 + bj) * DFF + j0), m1);
                if (!first) unpack8(*(const u32x4*)(halo + ((size_t)((seg - 1) * 4 + 3) * 2 + bj) * DFF + j0), m2); }
            else if (!first) { unpack8(*(const u32x4*)(halo + ((size_t)((seg - 1) * 4 + 3) * 2 + bj) * DFF + j0), m1);
                unpack8(*(const u32x4*)(halo + ((size_t)((seg - 1) * 4 + 2) * 2 + bj) * DFF + j0), m2); }
#pragma unroll
            for (int e = 0; e < 8; ++e) o[bj][e] = fb[col + e] + fw[2 * NUP + col + e] * cur[e] + fw[NUP + col + e] * m1[e] + fw[col + e] * m2[e];
        }
        float r8[8];
#pragma unroll
        for (int e = 0; e < 8; ++e) r8[e] = siluf_(o[0][e]) * o[1][e];
        *(u32x4*)(act + t * DFF + j0) = pack8(r8);
    }
}
#define GAS __attribute__((address_space(1)))
struct TileDesc { const float* W; bf16_t* WT; const float* ks; int ldw, K, k0, n0, src; };
constexpr int TW_IN = 8 * 40, TW_OUT = 8 * 16, TW_UP = 8 * 88, TW_DN = 22 * 16, TW_PW = 4 * 2;
constexpr int TW_A = TW_IN, TW_B = TW_A + TW_PW, TW_END = TW_B + TW_OUT + TW_UP + TW_DN;
__device__ __forceinline__ TileDesc tile_desc(const Args& a, int it) {
    TileDesc t; int r = it; t.ks = nullptr;
    if (r < TW_IN) { const int kb = r / 40, nb = r % 40, n0 = nb * 64; t.W = a.in[2]; t.ldw = 2568; t.WT = (bf16_t*)(a.ws + WS_WIN); t.K = 1024; t.k0 = kb * 128; t.n0 = n0; t.src = n0 < 2048 ? n0 : n0 + 8; t.ks = a.in[1]; return t; }
    r -= TW_IN;
    if (r < TW_PW) { const int kb = r / 2, nb = r % 2; t.W = a.in[7]; t.ldw = 128; t.WT = (bf16_t*)(a.ws + WS_PWT); t.K = 512; t.k0 = kb * 128; t.n0 = nb * 64; t.src = nb * 64; return t; }
    r -= TW_PW;
    if (r < TW_OUT) { const int kb = r / 16, nb = r % 16; t.W = a.in[10]; t.ldw = 1024; t.WT = (bf16_t*)(a.ws + WS_WOUT); t.K = 1024; t.k0 = kb * 128; t.n0 = nb * 64; t.src = nb * 64; return t; }
    r -= TW_OUT;
    if (r < TW_UP) { const int kb = r / 88, nb = r % 88, n0 = nb * 64, pn = n0 >> 8, rr = n0 & 255; t.W = a.in[12]; t.ldw = NUP; t.WT = (bf16_t*)(a.ws + WS_WUP); t.K = 1024; t.k0 = kb * 128; t.n0 = n0;
        t.src = (rr >> 7) * DFF + pn * 128 + (rr & 127); t.ks = a.in[11]; return t; }
    r -= TW_UP;
    { const int kb = r / 16, nb = r % 16; t.W = a.in[15]; t.ldw = 1024; t.WT = (bf16_t*)(a.ws + WS_WDOWN); t.K = DFF; t.k0 = kb * 128; t.n0 = nb * 64; t.src = nb * 64; return t; }
}
__device__ __forceinline__ void tile_load(const TileDesc& t, float (&v)[16]) {
    const int tid = threadIdx.x;
#pragma unroll
    for (int i = 0; i < 16; ++i) { const int kk = i * 8 + (tid >> 6), j = tid & 63; v[i] = t.W[(size_t)(t.k0 + kk) * t.ldw + t.src + j]; }
    if (t.ks) { float sc[16];
#pragma unroll
        for (int i = 0; i < 16; ++i) sc[i] = t.ks[t.k0 + i * 8 + (tid >> 6)];
#pragma unroll
        for (int i = 0; i < 16; ++i) v[i] *= sc[i]; }
}
__device__ __forceinline__ void phase_weights(const Args& a, PG8_LAS float* tile, int lo, int NTILES, int bid, int nb) {
    const int tid = threadIdx.x;
    int it = lo + bid; if (it >= NTILES) return;
    TileDesc cur = tile_desc(a, it); float v[16]; tile_load(cur, v);
    for (;;) {
#pragma unroll
        for (int i = 0; i < 16; ++i) tile[(i * 8 + (tid >> 6)) * 65 + (tid & 63)] = v[i];
        __syncthreads();
        const int nit = it + nb; const bool more = nit < NTILES; TileDesc nx = cur;
        if (more) { nx = tile_desc(a, nit); tile_load(nx, v); }
#pragma unroll
        for (int hh = 0; hh < 2; ++hh) { const int pidx = tid + 512 * hh, j = pidx >> 4, c = pidx & 15; const PG8_LAS float* s = tile + (8 * c) * 65 + j;
          u32x4 o; o.x = pk2(s[0], s[65]); o.y = pk2(s[130], s[195]); o.z = pk2(s[260], s[325]); o.w = pk2(s[390], s[455]);
          *(u32x4*)(cur.WT + (size_t)(cur.n0 + j) * cur.K + cur.k0 + 8 * c) = o; }
        __syncthreads();
        if (!more) break;
        cur = nx; it = nit;
    }
}
__device__ __forceinline__ void phase_norm1(const Args& a, float* wba) {
    const int tid = threadIdx.x, lane = tid & 63, wave = tid >> 6;
    const float* x = a.in[0]; const float* nw1 = a.in[1]; const float* w_in = a.in[2];
    bf16_t* h1b = (bf16_t*)a.out; float* rs1 = (float*)(a.ws + WS_RS1); float* betaB = (float*)(a.ws + WS_BETA); float* gB = (float*)(a.ws + WS_G);
    for (int k = tid; k < 1024; k += NT) { const float nw = nw1[k];
#pragma unroll
        for (int c = 0; c < 8; ++c) wba[c * 1024 + k] = w_in[(size_t)k * 2568 + 2048 + c] * nw; }
    __syncthreads();
    const int hh = (lane >> 3) & 3; const float alog = a.in[4][hh], dtb = a.in[5][hh]; const float aexp = -__expf(alog);
    f32x4 nwv[4];
#pragma unroll
    for (int j = 0; j < 4; ++j) nwv[j] = *(const f32x4*)(nw1 + 256 * j + 4 * lane);
    for (int row = blockIdx.x * 8 + wave; row < M; row += gridDim.x * 8) {
        const f32x4* xr = (const f32x4*)(x + (size_t)row * 1024) + lane;
        f32x4 v[4]; float ss = 0.f;
#pragma unroll
        for (int j = 0; j < 4; ++j) { v[j] = xr[64 * j]; ss += (v[j][0] * v[j][0] + v[j][1] * v[j][1]) + (v[j][2] * v[j][2] + v[j][3] * v[j][3]); }
        ss = wave_sum(ss); const float rstd = rsqrtf(ss * (1.0f / 1024.0f) + EPS);
        float d[8];
#pragma unroll
        for (int c = 0; c < 8; ++c) { float s = 0.f;
#pragma unroll
            for (int j = 0; j < 4; ++j) { const f32x4 w = *(const f32x4*)(wba + c * 1024 + 256 * j + 4 * lane); s += (v[j][0] * w[0] + v[j][1] * w[1]) + (v[j][2] * w[2] + v[j][3] * w[3]); }
            d[c] = s; }
        float dsum;
        { const bool b5 = lane & 32, b4 = lane & 16, b3 = lane & 8; float r4[4], r2[2];
#pragma unroll
          for (int i = 0; i < 4; ++i) { const float snd = b5 ? d[i] : d[4 + i], kp = b5 ? d[4 + i] : d[i]; r4[i] = kp + __shfl_xor(snd, 32); }
#pragma unroll
          for (int i = 0; i < 2; ++i) { const float snd = b4 ? r4[i] : r4[2 + i], kp = b4 ? r4[2 + i] : r4[i]; r2[i] = kp + __shfl_xor(snd, 16); }
          { const float snd = b3 ? r2[0] : r2[1], kp = b3 ? r2[1] : r2[0]; dsum = kp + __shfl_xor(snd, 8); }
          dsum += __shfl_xor(dsum, 4); dsum += __shfl_xor(dsum, 2); dsum += __shfl_xor(dsum, 1); dsum *= rstd; }
        bf16_t* hr = h1b + (size_t)row * 1024 + 4 * lane;
#pragma unroll
        for (int j = 0; j < 4; ++j) { const f32x4 h = v[j]; u32x2 w; w.x = pk2(h[0], h[1]); w.y = pk2(h[2], h[3]); *(u32x2*)(hr + 256 * j) = w; }
        if (lane == 0) rs1[row] = rstd;
        if ((lane & 7) == 0) { const int c = lane >> 3;
            if (c < 4) betaB[(size_t)row * 4 + c] = sigmoidf_(dsum);
            else { const float z = dsum + dtb; const float sp = z > 20.f ? z : log1pf(__expf(z)); gB[(size_t)row * 4 + (c - 4)] = aexp * sp; } }
    }
}

__device__ __forceinline__ void phase_qkv(const Args& a) {
    const int tid = threadIdx.x, lane = tid & 63, wave = tid >> 6;
    const bf16_t* proj = (const bf16_t*)(a.ws + WS_PROJ); const float* cw = a.in[3];
    for (int item = blockIdx.x * 8 + wave; item < 6144; item += gridDim.x * 8) {
        const int part = item % 3, rg = item / 3, rowA = rg * 16, pos0 = rowA & 2047, ch0 = part * 512 + 8 * lane;
        float w[4][8];
#pragma unroll
        for (int i = 0; i < 4; ++i) { const f32x4 w0 = *(const f32x4*)(cw + i * 1536 + ch0), w1 = *(const f32x4*)(cw + i * 1536 + ch0 + 4);
            w[i][0] = w0[0]; w[i][1] = w0[1]; w[i][2] = w0[2]; w[i][3] = w0[3]; w[i][4] = w1[0]; w[i][5] = w1[1]; w[i][6] = w1[2]; w[i][7] = w1[3]; }
        u32x4 R[19];
#pragma unroll
        for (int j = 0; j < 19; ++j) { const int dr = j - 3; const int rr = (pos0 + dr >= 0) ? rowA + dr : rowA; R[j] = *(const u32x4*)(proj + (size_t)rr * NPROJ + ch0); }
        bf16_t* dst = (bf16_t*)(a.ws + (part == 0 ? WS_QB : WS_KB)) + (size_t)rowA * 512 + 8 * lane;
        const float qsc = (part == 0) ? 0.08838834764831845f : 1.0f;
        u32x4 yb[16]; float F[19][8];
#pragma unroll
        for (int m = 0; m < 16; ++m) {
            float acc[8];
#pragma unroll
            for (int e = 0; e < 8; ++e) acc[e] = 0.f;
            if (m == 0) { unpack8(R[0], F[0]); unpack8(R[1], F[1]); unpack8(R[2], F[2]); }
            unpack8(R[m + 3], F[m + 3]);
#pragma unroll
            for (int i = 0; i < 4; ++i) {
                if (m + i < 3) { const float vm = (pos0 + m + i - 3 >= 0) ? 1.0f : 0.0f;
#pragma unroll
                    for (int e = 0; e < 8; ++e) acc[e] += F[m + i][e] * (w[i][e] * vm); }
                else {
#pragma unroll
                    for (int e = 0; e < 8; ++e) acc[e] += F[m + i][e] * w[i][e]; } }
            float ssq = 0.f;
#pragma unroll
            for (int e = 0; e < 8; ++e) { acc[e] = siluf_(acc[e]); ssq += acc[e] * acc[e]; }
            if (part < 2) { ssq = sum16(ssq); const float sc = rsqrtf(ssq + EPS) * qsc;
#pragma unroll
                for (int e = 0; e < 8; ++e) acc[e] *= sc; }
            yb[m] = pack8(acc);
            if (part < 2) *(u32x4*)(dst + (size_t)m * 512) = yb[m];
        }
        if (part > 0) {
            bf16_t* tb = (bf16_t*)(a.ws + (part == 1 ? WS_KT : WS_VT)) + ((size_t)(rg >> 2) * 512 + 8 * lane) * 64 + (rg & 3) * 16;
#pragma unroll
            for (int e = 0; e < 8; ++e) { u32x4 o0, o1;
#pragma unroll
                for (int pp = 0; pp < 8; ++pp) { const unsigned A = yb[2 * pp][e >> 1], B = yb[2 * pp + 1][e >> 1];
                    const unsigned v = (e & 1) ? ((A >> 16) | (B & 0xffff0000u)) : ((A & 0xffffu) | (B << 16));
                    if (pp < 4) o0[pp] = v; else o1[pp - 4] = v; }
                *(u32x4*)(tb + e * 64) = o0; *(u32x4*)(tb + e * 64 + 8) = o1; }
        }
    }
}
typedef pg8::bf16x8 bf16x8;
#define MFMA16(a, b, c) __builtin_amdgcn_mfma_f32_16x16x32_bf16((a), (b), (c), 0, 0, 0)
constexpr size_t WS_GL = 27 * MBY, WS_PREP = 352 * MBY, WS_OF2 = 256 * MBY;
constexpr int PREP_ITEM = 73728, PI_W = 0, PI_QG = 16384, PI_KD = 32768, PI_UT = 49152, PI_AQ = 65536;
__host__ __device__ __forceinline__ constexpr int perm32s(int o) { return 8 * ((o >> 2) & 3) + 4 * (o >> 4) + (o & 3); }
__host__ __device__ __forceinline__ constexpr int tokofpos(int p) { return (p & 32) + 16 * ((p & 7) >> 2) + 4 * ((p >> 3) & 3) + (p & 3); }
__device__ __forceinline__ bf16x8 packf8(const f32x4 lo, const f32x4 hi) { u32x4 p; p.x = pk2(lo[0], lo[1]); p.y = pk2(lo[2], lo[3]); p.z = pk2(hi[0], hi[1]); p.w = pk2(hi[2], hi[3]); return __builtin_bit_cast(bf16x8, p); }
__device__ __forceinline__ bf16_t f2bf(float x) { return (bf16_t)(pk2(x, x) & 0xffffu); }
__device__ __forceinline__ float bf2f(bf16_t x) { return __uint_as_float(((unsigned)x) << 16); }

__device__ __forceinline__ void solve64(float (&x)[64], const PG8_LAS float* sLt) {
    f32x4 cur[16];
#pragma unroll
    for (int i4 = 0; i4 < 16; ++i4) cur[i4] = *(const PG8_LAS f32x4*)(sLt + 4 * i4);
    asm volatile("" ::: "memory");
#pragma unroll
    for (int j = 0; j < 63; ++j) {
        const float xj = x[j];
#pragma unroll
        for (int i4 = (j + 1) / 4; i4 < 16; ++i4) {
            if (4 * i4 + 0 > j) x[4 * i4 + 0] -= cur[i4][0] * xj;
            if (4 * i4 + 1 > j) x[4 * i4 + 1] -= cur[i4][1] * xj;
            if (4 * i4 + 2 > j) x[4 * i4 + 2] -= cur[i4][2] * xj;
            if (4 * i4 + 3 > j) x[4 * i4 + 3] -= cur[i4][3] * xj;
            if (j + 1 < 63 && i4 >= (j + 2) / 4) cur[i4] = *(const PG8_LAS f32x4*)(sLt + (j + 1) * 64 + 4 * i4); }
        asm volatile("" ::: "memory");
    }
}

__device__ __forceinline__ void phase_prep(const Args& a, PG8_LAS unsigned char* lds) {
    const int tid = threadIdx.x, lane = tid & 63, wave = __builtin_amdgcn_readfirstlane(tid >> 6), half = wave >> 2, lw = wave & 3, q = lane >> 4, r = lane & 15;
    const int role = (lw - half) & 3;
    PG8_LAS unsigned char* hb = lds + half * 36864;
    PG8_LAS float* sG = (PG8_LAS float*)hb; PG8_LAS float* sB = sG + 64; PG8_LAS float* sE = sG + 128; PG8_LAS float* sK = sG + 192; PG8_LAS float* sL = sG + 256;
    PG8_LAS unsigned char* Tu = hb + 17408; PG8_LAS unsigned char* Tw = Tu + 9216;
    const bf16_t* qb = (const bf16_t*)(a.ws + WS_QB); const bf16_t* kb = (const bf16_t*)(a.ws + WS_KB);
    const bf16_t* kT = (const bf16_t*)(a.ws + WS_KT); const bf16_t* vT = (const bf16_t*)(a.ws + WS_VT);
    const float* betaB = (const float*)(a.ws + WS_BETA); const float* gB = (const float*)(a.ws + WS_G); float* glast = (float*)(a.ws + WS_GL);
    for (int unit = blockIdx.x; unit < 1024; unit += gridDim.x) {
        const int hp = unit & 1, bn = unit >> 1, h = 2 * hp + half, item = bn * 4 + h; const size_t r0 = (size_t)bn * 64;
        unsigned char* pi = a.ws + WS_PREP + (size_t)item * PREP_ITEM;
        bf16_t* wp = (bf16_t*)(pi + PI_W); bf16_t* qgp = (bf16_t*)(pi + PI_QG); bf16_t* kdTp = (bf16_t*)(pi + PI_KD); bf16_t* uT = (bf16_t*)(pi + PI_UT); bf16_t* aqkp = (bf16_t*)(pi + PI_AQ);
        const bf16_t* qbase = qb + r0 * 512 + h * 128; const bf16_t* kbase = kb + r0 * 512 + h * 128;
        const bf16_t* kTb = kT + ((size_t)bn * 512 + h * 128) * 64; const bf16_t* vTb = vT + ((size_t)bn * 512 + h * 128) * 64;
        bf16x8 ak[4], aq[4], bkf[2][4];
#pragma unroll
        for (int s = 0; s < 4; ++s) { ak[s] = *(const bf16x8*)(kbase + (size_t)(16 * lw + r) * 512 + 32 * s + 8 * q); aq[s] = *(const bf16x8*)(qbase + (size_t)(16 * lw + r) * 512 + 32 * s + 8 * q); }
#pragma unroll
        for (int tj = 0; tj < 2; ++tj)
#pragma unroll
            for (int s = 0; s < 4; ++s) bkf[tj][s] = *(const bf16x8*)(kbase + (size_t)(16 * tj + r) * 512 + 32 * s + 8 * q);
        bf16x8 pv[2][2], pk[2][2];
        if (role != 0) {
#pragma unroll
        for (int cc = 0; cc < 2; ++cc) { const int ct = 2 * lw + cc;
            pv[cc][0] = *(const bf16x8*)(vTb + (size_t)(16 * ct + r) * 64 + 8 * q); pv[cc][1] = *(const bf16x8*)(vTb + (size_t)(16 * ct + r) * 64 + 32 + 8 * q);
            pk[cc][0] = *(const bf16x8*)(kTb + (size_t)(16 * ct + r) * 64 + 8 * q); pk[cc][1] = *(const bf16x8*)(kTb + (size_t)(16 * ct + r) * 64 + 32 + 8 * q); } }
        float gv = gB[(r0 + lane) * 4 + h];
#pragma unroll
        for (int off = 1; off < 64; off <<= 1) { const float t = __shfl_up(gv, off); if (lane >= off) gv += t; }
        const float g63 = __shfl(gv, 63);
        if (lw == 0) { sG[lane] = gv; sB[lane] = betaB[(r0 + lane) * 4 + h]; sE[lane] = __expf(gv); sK[lane] = __expf(g63 - gv); }
        if ((tid & 255) == 0) glast[item] = __expf(g63);
        __syncthreads();
        {
#pragma unroll
            for (int tj = 0; tj < 4; ++tj) {
                f32x4 ckk = {0.f, 0.f, 0.f, 0.f}, cqk = {0.f, 0.f, 0.f, 0.f};
#pragma unroll
                for (int s = 0; s < 4; ++s) { const bf16x8 bk = (tj < 2) ? bkf[tj & 1][s] : *(const bf16x8*)(kbase + (size_t)(16 * tj + r) * 512 + 32 * s + 8 * q); ckk = MFMA16(ak[s], bk, ckk); cqk = MFMA16(aq[s], bk, cqk); }
                const int j = 16 * tj + r; const float Gj = sG[j]; const int jpos = (j & 32) + perm32s(j & 31);
                f32x4 lv;
#pragma unroll
                for (int e = 0; e < 4; ++e) { const int i = 16 * lw + 4 * q + e; const float Gi = sG[i], bi = sB[i];
                    const float dec = (i >= j) ? __expf(Gi - Gj) : 0.f;
                    lv[e] = (i > j) ? ckk[e] * bi * dec : 0.f;
                    aqkp[i * 64 + jpos] = f2bf((i >= j) ? cqk[e] * dec : 0.f); }
                *(PG8_LAS f32x4*)(sL + j * 64 + 16 * lw + 4 * q) = lv;
            }
        }
        __syncthreads();
        if (role == 0) {
            float x[64];
#pragma unroll
            for (int i = 0; i < 64; ++i) x[i] = (i == lane) ? 1.0f : 0.0f;
            solve64(x, sL);
#pragma unroll
            for (int cc = 0; cc < 2; ++cc) { const int ct = 2 * lw + cc;
                pv[cc][0] = *(const bf16x8*)(vTb + (size_t)(16 * ct + r) * 64 + 8 * q); pv[cc][1] = *(const bf16x8*)(vTb + (size_t)(16 * ct + r) * 64 + 32 + 8 * q);
                pk[cc][0] = *(const bf16x8*)(kTb + (size_t)(16 * ct + r) * 64 + 8 * q); pk[cc][1] = *(const bf16x8*)(kTb + (size_t)(16 * ct + r) * 64 + 32 + 8 * q); }
            const float bj = sB[lane], bej = bj * sE[lane];
#pragma unroll
            for (int i = 0; i < 64; ++i) { *(PG8_LAS bf16_t*)(Tu + (i * 72 + lane) * 2) = f2bf(x[i] * bj); *(PG8_LAS bf16_t*)(Tw + (i * 72 + lane) * 2) = f2bf(x[i] * bej); }
        } else if (role == 1) {
#pragma unroll 4
            for (int k = 0; k < 16; ++k) { const int pidx = lane + 64 * k, i = pidx >> 4, pc = pidx & 15, aa = pc & 3, c32 = (pc >> 2) * 32;
                float f[8]; unpack8(*(const u32x4*)(qbase + (size_t)i * 512 + pc * 8), f); const float e = sE[i];
                u32x2 lo, hi; lo.x = pk2(f[0] * e, f[1] * e); lo.y = pk2(f[2] * e, f[3] * e); hi.x = pk2(f[4] * e, f[5] * e); hi.y = pk2(f[6] * e, f[7] * e);
                *(u32x2*)(qgp + i * 128 + c32 + 8 * ((2 * aa) & 3) + 4 * (aa >> 1)) = lo;
                *(u32x2*)(qgp + i * 128 + c32 + 8 * ((2 * aa + 1) & 3) + 4 * (aa >> 1)) = hi; }
        } else {
            const int d = (role - 2) * 64 + lane; float x[64];
#pragma unroll
            for (int c8 = 0; c8 < 8; ++c8) { float f[8]; unpack8(*(const u32x4*)(kTb + (size_t)d * 64 + 8 * c8), f);
#pragma unroll
                for (int e = 0; e < 8; ++e) x[8 * c8 + e] = f[e] * sK[8 * c8 + e]; }
#pragma unroll
            for (int c8 = 0; c8 < 8; ++c8) { u32x4 o;
                o.x = pk2(x[tokofpos(8 * c8 + 0)], x[tokofpos(8 * c8 + 1)]); o.y = pk2(x[tokofpos(8 * c8 + 2)], x[tokofpos(8 * c8 + 3)]);
                o.z = pk2(x[tokofpos(8 * c8 + 4)], x[tokofpos(8 * c8 + 5)]); o.w = pk2(x[tokofpos(8 * c8 + 6)], x[tokofpos(8 * c8 + 7)]);
                *(u32x4*)(kdTp + d * 64 + 8 * c8) = o; }
        }
        __syncthreads();
        {
            bf16x8 tf[4][2];
#pragma unroll
            for (int it = 0; it < 4; ++it)
#pragma unroll
                for (int s = 0; s < 2; ++s) tf[it][s] = *(const PG8_LAS bf16x8*)(Tu + ((16 * it + r) * 72 + 32 * s + 8 * q) * 2);
#pragma unroll
            for (int cc = 0; cc < 2; ++cc) { const int ct = 2 * lw + cc;
                const bf16x8 v0 = pv[cc][0], v1 = pv[cc][1];
#pragma unroll
                for (int it = 0; it < 4; ++it) { f32x4 acc = {0.f, 0.f, 0.f, 0.f}; acc = MFMA16(tf[it][0], v0, acc); acc = MFMA16(tf[it][1], v1, acc);
                    u32x2 w; w.x = pk2c(acc[0], acc[1]); w.y = pk2c(acc[2], acc[3]);
                    *(u32x2*)(uT + (16 * ct + r) * 64 + 16 * it + 4 * q) = w; } }
#pragma unroll
            for (int it = 0; it < 4; ++it)
#pragma unroll
                for (int s = 0; s < 2; ++s) tf[it][s] = *(const PG8_LAS bf16x8*)(Tw + ((16 * it + r) * 72 + 32 * s + 8 * q) * 2);
#pragma unroll
            for (int cc = 0; cc < 2; ++cc) { const int dt = 2 * lw + cc;
                const bf16x8 k0 = pk[cc][0], k1 = pk[cc][1];
                const int o4 = 16 * dt + 4 * q, dpos = (o4 & ~31) + perm32s(o4 & 31);
#pragma unroll
                for (int it = 0; it < 4; ++it) { f32x4 acc = {0.f, 0.f, 0.f, 0.f}; acc = MFMA16(k0, tf[it][0], acc); acc = MFMA16(k1, tf[it][1], acc);
                    u32x2 w; w.x = pk2c(acc[0], acc[1]); w.y = pk2c(acc[2], acc[3]);
                    *(u32x2*)(wp + (16 * it + r) * 128 + dpos) = w; } }
        }
        __syncthreads();
    }
}

__device__ __forceinline__ void phase_scan(const Args& a, PG8_LAS unsigned char* lds, int sblk) {
    const int tid = threadIdx.x, lane = tid & 63, wave = tid >> 6, q = lane >> 4, r = lane & 15;
    const int bh = sblk >> 1, dvh = sblk & 1, b = bh >> 2, h = bh & 3;
    bf16_t* of = (bf16_t*)(a.ws + WS_OF2); const float* glast = (const float*)(a.ws + WS_GL);
    constexpr int L_W = 0, L_QG = 17408, L_KD = 34816, L_UT = 53248, L_AQ = 71680;
    f32x4 S[8];
#pragma unroll
    for (int m = 0; m < 8; ++m) S[m] = (f32x4){0.f, 0.f, 0.f, 0.f};
    u32x4 pre[9];
    { const unsigned char* src = a.ws + WS_PREP + (size_t)((b * 32 + 0) * 4 + h) * PREP_ITEM;
#pragma unroll
      for (int i = 0; i < 9; ++i) pre[i] = *(const u32x4*)(src + (size_t)(tid + 512 * i) * 16); }
    for (int n = 0; n < 32; ++n) {
#pragma unroll
        for (int i = 0; i < 9; ++i) { const int p = tid + 512 * i; int off;
            if (i < 2) off = L_W + (p >> 4) * 272 + (p & 15) * 16;
            else if (i < 4) { const int pp = p - 1024; off = L_QG + (pp >> 4) * 272 + (pp & 15) * 16; }
            else if (i < 6) { const int pp = p - 2048; off = L_KD + (pp >> 3) * 144 + (pp & 7) * 16; }
            else if (i < 8) { const int pp = p - 3072; off = L_UT + (pp >> 3) * 144 + (pp & 7) * 16; }
            else { const int pp = p - 4096; off = L_AQ + (pp >> 3) * 144 + (pp & 7) * 16; }
            *(PG8_LAS u32x4*)(lds + off) = pre[i]; }
        __syncthreads();
        if (n + 1 < 32) { const unsigned char* src = a.ws + WS_PREP + (size_t)((b * 32 + n + 1) * 4 + h) * PREP_ITEM;
#pragma unroll
            for (int i = 0; i < 9; ++i) pre[i] = *(const u32x4*)(src + (size_t)(tid + 512 * i) * 16); }
        if (wave < 4) {
            const int dv0 = dvh * 64 + wave * 16; const float gl = glast[(b * 32 + n) * 4 + h]; const size_t row0 = (size_t)b * 2048 + n * 64;
            bf16x8 Sb[4];
#pragma unroll
            for (int s = 0; s < 4; ++s) Sb[s] = packf8(S[2 * s], S[2 * s + 1]);
            f32x4 vn[4];
#pragma unroll
            for (int mt = 0; mt < 4; ++mt) {
                const u32x2 uu = *(const PG8_LAS u32x2*)(lds + L_UT + (dv0 + r) * 144 + (16 * mt + 4 * q) * 2);
                f32x4 acc = {0.f, 0.f, 0.f, 0.f};
#pragma unroll
                for (int s = 0; s < 4; ++s) { const bf16x8 af = *(const PG8_LAS bf16x8*)(lds + L_W + (16 * mt + r) * 272 + (32 * s + 8 * q) * 2); acc = MFMA16(af, Sb[s], acc); }
                vn[mt] = (f32x4){bf_lo(uu.x), bf_hi(uu.x), bf_lo(uu.y), bf_hi(uu.y)} - acc;
            }
            bf16x8 Vb[2];
#pragma unroll
            for (int s = 0; s < 2; ++s) Vb[s] = packf8(vn[2 * s], vn[2 * s + 1]);
#pragma unroll
            for (int mt = 0; mt < 4; ++mt) {
                f32x4 o = {0.f, 0.f, 0.f, 0.f};
#pragma unroll
                for (int s = 0; s < 4; ++s) { const bf16x8 af = *(const PG8_LAS bf16x8*)(lds + L_QG + (16 * mt + r) * 272 + (32 * s + 8 * q) * 2); o = MFMA16(af, Sb[s], o); }
#pragma unroll
                for (int s = 0; s < 2; ++s) { const bf16x8 af = *(const PG8_LAS bf16x8*)(lds + L_AQ + (16 * mt + r) * 144 + (32 * s + 8 * q) * 2); o = MFMA16(af, Vb[s], o); }
#pragma unroll
                for (int e = 0; e < 4; ++e) of[(row0 + 16 * mt + 4 * q + e) * 512 + h * 128 + dv0 + r] = (bf16_t)(pk2c(o[e], o[e]) & 0xffffu);
            }
#pragma unroll
            for (int mt = 0; mt < 8; ++mt) {
                f32x4 acc = S[mt] * gl;
#pragma unroll
                for (int s = 0; s < 2; ++s) { const bf16x8 af = *(const PG8_LAS bf16x8*)(lds + L_KD + (16 * mt + r) * 144 + (32 * s + 8 * q) * 2); acc = MFMA16(af, Vb[s], acc); }
                S[mt] = acc;
            }
        }
        __syncthreads();
    }
}
template <int WIN>
__device__ __forceinline__ void pool_fill(const bf16_t* proj, PG8_LAS unsigned char* lds, int row0, int gi) {
    const int tid = threadIdx.x, pc = tid & 15, tr = tid >> 4, tok0 = 4 * tr, rowA = row0 + tok0, pos0 = rowA & 2047;
    constexpr int NR = WIN + 3;
    u32x4 R[NR];
    const bf16_t* base = proj + 2048 + gi * 128 + pc * 8;
#pragma unroll
    for (int j = 0; j < NR; ++j) { const int dr = j - (WIN - 1); const int rr = (pos0 + dr >= 0) ? rowA + dr : rowA; R[j] = *(const u32x4*)(base + (size_t)rr * NPROJ); }
    float s[8];
#pragma unroll
    for (int e = 0; e < 8; ++e) s[e] = 0.f;
#pragma unroll
    for (int j = 0; j < WIN; ++j) { float f[8]; unpack8(R[j], f); const float vm = (pos0 + j - (WIN - 1) >= 0) ? 1.0f : 0.0f;
#pragma unroll
        for (int e = 0; e < 8; ++e) s[e] += vm * f[e]; }
#pragma unroll
    for (int m = 0; m < 4; ++m) {
        float u[8]; unpack8(R[WIN - 1 + m], u);
        if (m > 0) { float o[8]; unpack8(R[m - 1], o); const float vm = (pos0 + m - WIN >= 0) ? 1.0f : 0.0f;
#pragma unroll
            for (int e = 0; e < 8; ++e) s[e] += u[e] - vm * o[e]; }
        const int n = (pos0 + m + 1) < WIN ? (pos0 + m + 1) : WIN; const float inv = 1.0f / (float)n; float d[8];
#pragma unroll
        for (int e = 0; e < 8; ++e) d[e] = s[e] * inv - u[e];
        *(PG8_LAS u32x4*)(lds + (tok0 + m) * 272 + pc * 16) = pack8(d);
    }
}
__device__ __forceinline__ void phase_pool(const Args& a, PG8_LAS unsigned char* lds, int bid, int nb) {
    const int tid = threadIdx.x, lane = tid & 63, wave = tid >> 6, q = lane >> 4, r = lane & 15;
    const bf16_t* proj = (const bf16_t*)(a.ws + WS_PROJ); bf16_t* mix = (bf16_t*)(a.ws + WS_MIX); const bf16_t* pwt = (const bf16_t*)(a.ws + WS_PWT);
    const int gi = bid & 3;
    constexpr int L_WT = 34816, L_PB = L_WT + 128 * 272;
#pragma unroll
    for (int k = 0; k < 4; ++k) { const int idx = tid + 512 * k, row = idx >> 4, pc = idx & 15;
        *(PG8_LAS u32x4*)(lds + L_WT + row * 272 + pc * 16) = *(const u32x4*)(pwt + (size_t)row * 512 + gi * 128 + pc * 8); }
    if (tid < 128) { ((PG8_LAS float*)(lds + L_PB))[tid] = a.in[8][gi * 128 + tid]; ((PG8_LAS float*)(lds + L_PB))[128 + tid] = a.in[9][gi * 128 + tid]; }
    __syncthreads();
    for (int item = bid; item < 1024; item += nb) {
        const int tile = item >> 2, row0 = tile * 128;
        if (gi == 0) pool_fill<2>(proj, lds, row0, 0); else if (gi == 1) pool_fill<4>(proj, lds, row0, 1); else if (gi == 2) pool_fill<8>(proj, lds, row0, 2); else pool_fill<16>(proj, lds, row0, 3);
        __syncthreads();
        { bf16x8 df[4];
#pragma unroll
          for (int s = 0; s < 4; ++s) df[s] = *(const PG8_LAS bf16x8*)(lds + (16 * wave + r) * 272 + (32 * s + 8 * q) * 2);
#pragma unroll
          for (int nt = 0; nt < 8; ++nt) { f32x4 acc = {0.f, 0.f, 0.f, 0.f};
#pragma unroll
              for (int s = 0; s < 4; ++s) { const bf16x8 wf = *(const PG8_LAS bf16x8*)(lds + L_WT + (16 * nt + r) * 272 + (32 * s + 8 * q) * 2); acc = MFMA16(wf, df[s], acc); }
              const int dl = 16 * nt + 4 * q; const f32x4 o = (acc + *(const PG8_LAS f32x4*)(lds + L_PB + dl * 4)) * *(const PG8_LAS f32x4*)(lds + L_PB + 512 + dl * 4);
              u32x2 w; w.x = pk2(o[0], o[1]); w.y = pk2(o[2], o[3]);
              *(u32x2*)(mix + (size_t)(row0 + 16 * wave + r) * 1024 + 512 + gi * 128 + dl) = w; } }
        __syncthreads();
    }
}
__device__ __forceinline__ void phase_gate(const Args& a) {
    const int tid = threadIdx.x, lane = tid & 63, wave = tid >> 6;
    const bf16_t* proj = (const bf16_t*)(a.ws + WS_PROJ); const bf16_t* of = (const bf16_t*)(a.ws + WS_OF2); bf16_t* mix = (bf16_t*)(a.ws + WS_MIX);
    const float* onw = a.in[6]; const int c0 = (8 * lane) & 127;
    const f32x4 w0 = *(const f32x4*)(onw + c0), w1 = *(const f32x4*)(onw + c0 + 4);
    for (int row = blockIdx.x * 8 + wave; row < M; row += gridDim.x * 8) {
        float of8[8]; unpack8(*(const u32x4*)(of + (size_t)row * 512 + 8 * lane), of8);
        const f32x4 o0 = {of8[0], of8[1], of8[2], of8[3]}, o1 = {of8[4], of8[5], of8[6], of8[7]};
        float ss = (o0[0] * o0[0] + o0[1] * o0[1]) + (o0[2] * o0[2] + o0[3] * o0[3]) + (o1[0] * o1[0] + o1[1] * o1[1]) + (o1[2] * o1[2] + o1[3] * o1[3]);
        ss = sum16(ss); const float r = rsqrtf(ss * (1.0f / 128.0f) + EPS);
        float z[8]; unpack8(*(const u32x4*)(proj + (size_t)row * NPROJ + 1536 + 8 * lane), z);
        float y[8];
        y[0] = o0[0] * r * w0[0] * siluf_(z[0]); y[1] = o0[1] * r * w0[1] * siluf_(z[1]); y[2] = o0[2] * r * w0[2] * siluf_(z[2]); y[3] = o0[3] * r * w0[3] * siluf_(z[3]);
        y[4] = o1[0] * r * w1[0] * siluf_(z[4]); y[5] = o1[1] * r * w1[1] * siluf_(z[5]); y[6] = o1[2] * r * w1[2] * siluf_(z[6]); y[7] = o1[3] * r * w1[3] * siluf_(z[7]);
        *(u32x4*)(mix + (size_t)row * 1024 + 8 * lane) = pack8(y);
    }
}
__device__ __forceinline__ void phase_ffnconv(const Args& a, int hf) {
    const bf16_t* up = (const bf16_t*)(a.ws + WS_UPH); bf16_t* act = (bf16_t*)(a.ws + WS_ACT);
    const float* fw = a.in[13]; const float* fb = a.in[14];
    const int total = 16384 * 352;
    for (int it = blockIdx.x * NT + threadIdx.x; it < total; it += gridDim.x * NT) {
        const int rl = it / 352, p = it - rl * 352, j0 = p * 8, pn = j0 >> 7, jj = j0 & 127, row = hf * 16384 + rl, t = row & 2047, gcol = 256 * pn + jj;
        float g[8], v[8];
        { const f32x4 b0 = *(const f32x4*)(fb + j0), b1 = *(const f32x4*)(fb + j0 + 4), c0 = *(const f32x4*)(fb + DFF + j0), c1 = *(const f32x4*)(fb + DFF + j0 + 4);
          g[0] = b0[0]; g[1] = b0[1]; g[2] = b0[2]; g[3] = b0[3]; g[4] = b1[0]; g[5] = b1[1]; g[6] = b1[2]; g[7] = b1[3];
          v[0] = c0[0]; v[1] = c0[1]; v[2] = c0[2]; v[3] = c0[3]; v[4] = c1[0]; v[5] = c1[1]; v[6] = c1[2]; v[7] = c1[3]; }
#pragma unroll
        for (int i = 0; i < 3; ++i) { if (t - 2 + i >= 0) {
            float gf[8], vf[8]; unpack8(*(const u32x4*)(up + (size_t)(rl - 2 + i) * NUP + gcol), gf); unpack8(*(const u32x4*)(up + (size_t)(rl - 2 + i) * NUP + gcol + 128), vf);
            const float* wg = fw + (size_t)i * NUP + j0; const float* wv = wg + DFF;
            const f32x4 a0 = *(const f32x4*)wg, a1 = *(const f32x4*)(wg + 4), e0 = *(const f32x4*)wv, e1 = *(const f32x4*)(wv + 4);
            g[0] += gf[0] * a0[0]; g[1] += gf[1] * a0[1]; g[2] += gf[2] * a0[2]; g[3] += gf[3] * a0[3]; g[4] += gf[4] * a1[0]; g[5] += gf[5] * a1[1]; g[6] += gf[6] * a1[2]; g[7] += gf[7] * a1[3];
            v[0] += vf[0] * e0[0]; v[1] += vf[1] * e0[1]; v[2] += vf[2] * e0[2]; v[3] += vf[3] * e0[3]; v[4] += vf[4] * e1[0]; v[5] += vf[5] * e1[1]; v[6] += vf[6] * e1[2]; v[7] += vf[7] * e1[3]; } }
        float o[8];
#pragma unroll
        for (int e = 0; e < 8; ++e) o[e] = siluf_(g[e]) * v[e];
        *(u32x4*)(act + (size_t)row * DFF + j0) = pack8(o);
    }
}
__device__ __forceinline__ void phase_final(const Args& a) {
    const int tid = threadIdx.x, lane = tid & 63, wave = tid >> 6; const float* fw = a.in[16];
    const bf16_t* yb = (const bf16_t*)(a.ws + WS_YB); const float* ss3 = (const float*)(a.ws + WS_SS3);
    f32x4 nwv[4];
#pragma unroll
    for (int j = 0; j < 2; ++j) { nwv[2 * j] = *(const f32x4*)(fw + 512 * j + 8 * lane); nwv[2 * j + 1] = *(const f32x4*)(fw + 512 * j + 8 * lane + 4); }
    for (int row = blockIdx.x * 8 + wave; row < M; row += gridDim.x * 8) {
        const u32x4 y0 = *(const u32x4*)(yb + (size_t)row * 1024 + 8 * lane), y1 = *(const u32x4*)(yb + (size_t)row * 1024 + 512 + 8 * lane);
        const f32x4 s0 = *(const f32x4*)(ss3 + (size_t)row * 16), s1 = *(const f32x4*)(ss3 + (size_t)row * 16 + 4), s2 = *(const f32x4*)(ss3 + (size_t)row * 16 + 8), s3 = *(const f32x4*)(ss3 + (size_t)row * 16 + 12);
        const float ss = ((s0[0] + s0[1]) + (s0[2] + s0[3])) + ((s1[0] + s1[1]) + (s1[2] + s1[3])) + ((s2[0] + s2[1]) + (s2[2] + s2[3])) + ((s3[0] + s3[1]) + (s3[2] + s3[3]));
        const float rstd = rsqrtf(ss * (1.0f / 1024.0f) + EPS);
        float f0[8], f1[8]; unpack8(y0, f0); unpack8(y1, f1);
        float* op = a.out + (size_t)row * 1024 + 8 * lane;
        *(f32x4*)op = (f32x4){f0[0], f0[1], f0[2], f0[3]} * rstd * nwv[0]; *(f32x4*)(op + 4) = (f32x4){f0[4], f0[5], f0[6], f0[7]} * rstd * nwv[1];
        *(f32x4*)(op + 512) = (f32x4){f1[0], f1[1], f1[2], f1[3]} * rstd * nwv[2]; *(f32x4*)(op + 516) = (f32x4){f1[4], f1[5], f1[6], f1[7]} * rstd * nwv[3];
    }
}

#define XB_TMO      128
#define XB_XCNT(j)  (256  + 64 * (j))
#define XB_XSUB(j)  (1280 + 64 * (j))
#define XB_XGEN(j)  (2304 + 64 * (j))
#define XB_TOP      3328
#define XB_TOPGEN   3392
#define XCD_BAR_WORDS 3456
#define XB_SPIN_CAP (1u << 18)
#define LAS __attribute__((address_space(3)))

__device__ __forceinline__ unsigned xb_ld(unsigned* p)              { return __hip_atomic_load(p, __ATOMIC_RELAXED, __HIP_MEMORY_SCOPE_AGENT); }
__device__ __forceinline__ unsigned xb_add(unsigned* p, unsigned v) { return __hip_atomic_fetch_add(p, v, __ATOMIC_RELAXED, __HIP_MEMORY_SCOPE_AGENT); }
__device__ __forceinline__ unsigned xb_xcc_id() { return (unsigned)__builtin_amdgcn_s_getreg((3 << 11) | 20) & 0xFu; }
#define XB_SPIN(cond, bar) do { unsigned _sp = 0; while (cond) { __builtin_amdgcn_s_sleep(1); \
    if ((++_sp & 255u) == 0u) { if (xb_ld(&(bar)[XB_TMO])) break; if (_sp > XB_SPIN_CAP) { atomicAdd(&(bar)[XB_TMO], 1u); break; } } } } while (0)

struct XcdBarrier {
    unsigned* bar; unsigned x;
    volatile LAS unsigned* st;
};

__device__ __forceinline__ XcdBarrier xcd_barrier_post(unsigned* bar, volatile LAS unsigned* st) {
    XcdBarrier b; b.bar = bar; b.x = xb_xcc_id(); b.st = st;
    if (threadIdx.x == 0) (void)xb_add(&bar[XB_XCNT(b.x)], 1u);
    return b;
}
__device__ __forceinline__ void xcd_barrier_complete(unsigned* bar, unsigned x, unsigned& nloc, unsigned& nx) {
    const unsigned G = gridDim.x * gridDim.y * gridDim.z;
    unsigned sum, cnt, mine, sp = 0u;
    for (;;) {
        sum = 0u; cnt = 0u; mine = 0u;
#pragma unroll
        for (unsigned j = 0; j < 16; ++j) { const unsigned c = xb_ld(&bar[XB_XCNT(j)]); sum += c; cnt += (c > 0u) ? 1u : 0u; mine = (j == x) ? c : mine; }
        if (sum == G) break;
        __builtin_amdgcn_s_sleep(1);
        if ((++sp & 255u) == 0u) { if (xb_ld(&bar[XB_TMO])) break; if (sp > XB_SPIN_CAP) { atomicAdd(&bar[XB_TMO], 1u); break; } }
    }
    nloc = mine > 0u ? mine : 1u; nx = cnt > 0u ? cnt : 1u;
}

__device__ __forceinline__ void xcd_barrier(const XcdBarrier& b) {
    asm volatile("s_waitcnt vmcnt(0)" ::: "memory");
    __syncthreads();
    if (threadIdx.x == 0) {
        unsigned* bar = b.bar;
        __builtin_amdgcn_s_waitcnt(0);
        unsigned nloc = b.st[0], nx = b.st[1];
        if (nloc == 0u) { xcd_barrier_complete(bar, b.x, nloc, nx); b.st[0] = nloc; b.st[1] = nx; }
        const unsigned old = xb_add(&bar[XB_XSUB(b.x)], 1u);
        const unsigned gen = old / nloc;
        if (old + 1u == (gen + 1u) * nloc) {
            __builtin_amdgcn_fence(__ATOMIC_RELEASE, "agent");
            asm volatile("s_waitcnt vmcnt(0)" ::: "memory");
            const unsigned og = xb_add(&bar[XB_TOP], 1u);
            const unsigned tg = og / nx;
            if (og + 1u == (tg + 1u) * nx) xb_add(&bar[XB_TOPGEN], 1u);
            else XB_SPIN(xb_ld(&bar[XB_TOPGEN]) == tg, bar);
            __builtin_amdgcn_fence(__ATOMIC_ACQUIRE, "agent");
            xb_add(&bar[XB_XGEN(b.x)], 1u);
            asm volatile("s_waitcnt vmcnt(0)" ::: "memory");
        } else {
            XB_SPIN(xb_ld(&bar[XB_XGEN(b.x)]) == gen, bar);
            __builtin_amdgcn_fence(__ATOMIC_ACQUIRE, "agent");
            asm volatile("s_waitcnt vmcnt(0)" ::: "memory");
        }
    }
    __syncthreads();
}


__global__ void __launch_bounds__(NT) mega(Args a) {
    extern __shared__ __attribute__((aligned(16))) unsigned char lds_raw[];
    cg::grid_group grid = cg::this_grid();
    PG8_LAS unsigned char* lds = (PG8_LAS unsigned char*)lds_raw;
    volatile LAS unsigned* xst = (volatile LAS unsigned*)(lds + 131072);
    if (threadIdx.x < 4) xst[threadIdx.x] = 0u;
    __syncthreads();
    XcdBarrier xbar = xcd_barrier_post((unsigned*)(a.ws + WS_BAR), xst);
    bf16_t* WinT = (bf16_t*)(a.ws + WS_WIN); bf16_t* WoutT = (bf16_t*)(a.ws + WS_WOUT); bf16_t* WupT = (bf16_t*)(a.ws + WS_WUP); bf16_t* WdownT = (bf16_t*)(a.ws + WS_WDOWN);
    bf16_t* h1b = (bf16_t*)a.out; bf16_t* proj = (bf16_t*)(a.ws + WS_PROJ); bf16_t* mix = (bf16_t*)(a.ws + WS_MIX); bf16_t* xb = (bf16_t*)(a.ws + WS_XB);
    bf16_t* uph = (bf16_t*)(a.ws + WS_UPH); bf16_t* act = (bf16_t*)(a.ws + WS_ACT); float* ss2 = (float*)(a.ws + WS_SS2);

    const unsigned mk = a.mask;
    if (mk & 1u) { phase_weights(a, (PG8_LAS float*)lds, 0, TW_B, (int)blockIdx.x, (int)gridDim.x); }
    __syncthreads();
    if (mk & 2048u) phase_norm1(a, (float*)lds_raw);
    grid.sync();
    if (mk & 2u)
    { pg8::Gemm g{h1b, WinT, M, NPROJ, D}; pg8::StaticOrder S; S.init(M, NPROJ, (int)gridDim.x, (int)blockIdx.x); EpiBf16Plain E{proj, NPROJ, (const float*)(a.ws + WS_RS1)};
      pg8::gemm_phase<EpiBf16Plain, pg8::StaticOrder, true, true>(lds, g, S, E); }
    xcd_barrier(xbar);
    if (mk & 4u) phase_qkv(a);
    xcd_barrier(xbar);
    if (mk & 8u) phase_prep(a, lds);
    xcd_barrier(xbar);
    if (gridDim.x >= 256) { if (blockIdx.x < 128) { if (mk & 16u) phase_scan(a, lds, (int)blockIdx.x); } else if (mk & 4096u) { phase_pool(a, lds, (int)blockIdx.x - 128, (int)gridDim.x - 128); phase_weights(a, (PG8_LAS float*)lds, TW_B, TW_END, (int)blockIdx.x - 128, (int)gridDim.x - 128); } }
    else { if (mk & 16u) for (int sb = blockIdx.x; sb < 128; sb += gridDim.x) phase_scan(a, lds, sb); if (mk & 4096u) { phase_pool(a, lds, (int)blockIdx.x, (int)gridDim.x & ~3); phase_weights(a, (PG8_LAS float*)lds, TW_B, TW_END, (int)blockIdx.x, (int)gridDim.x); } }
    xcd_barrier(xbar);
    if (mk & 32u) phase_gate(a);
    xcd_barrier(xbar);
    if (mk & 64u)
    { pg8::Gemm g{mix, WoutT, M, D, D}; pg8::StaticOrder S; S.init(M, D, (int)gridDim.x, (int)blockIdx.x); EpiOutProj E{(const bf16_t*)a.out, xb, ss2};
      pg8::gemm_phase<EpiOutProj, pg8::StaticOrder, true, true>(lds, g, S, E); }
    xcd_barrier(xbar);
    if (mk & 128u)
    { pg8::Gemm g{xb, WupT, M, NUP, D}; pg8::StaticOrder S; S.init(M, NUP, (int)gridDim.x, (int)blockIdx.x); EpiUpFused E{act, (bf16_t*)(a.ws + WS_HALO), ss2, a.in[13], a.in[14], lds + 131072 + 256};
      pg8::gemm_phase<EpiUpFused, pg8::StaticOrder, true, true>(lds, g, S, E); }
    xcd_barrier(xbar);
    if (mk & 256u) phase_fixup(a);
    xcd_barrier(xbar);
    if (mk & 512u)
    { pg8::Gemm g{act, WdownT, M, D, DFF}; pg8::StaticOrder S; S.init(M, D, (int)gridDim.x, (int)blockIdx.x); EpiDown E{xb, (bf16_t*)(a.ws + WS_YB), (float*)(a.ws + WS_SS3)};
      pg8::gemm_phase<EpiDown, pg8::StaticOrder, true, true>(lds, g, S, E); }
    xcd_barrier(xbar);
    if (mk & 1024u) phase_final(a);
}

extern "C" void kernel_launch(void* const* d_in, const int* in_sizes, int n_in, void* d_out, int out_size, void* d_ws, size_t ws_size, hipStream_t stream) {
    static int grid_blocks = 0;
    if (!grid_blocks) {
        int dev = 0, cus = 0, per_cu = 0;
        (void)hipGetDevice(&dev);
        (void)hipDeviceGetAttribute(&cus, hipDeviceAttributeMultiprocessorCount, dev);
        (void)hipFuncSetAttribute((const void*)mega, hipFuncAttributeMaxDynamicSharedMemorySize, LDS_BYTES);
        (void)hipOccupancyMaxActiveBlocksPerMultiprocessor(&per_cu, (const void*)mega, NT, LDS_BYTES);
        if (per_cu < 1) { fprintf(stderr, "occupancy query says %d\n", per_cu); per_cu = 1; }
        if (per_cu > 1) per_cu = 1;
        grid_blocks = cus * per_cu;
        if (ws_size < WS_END) fprintf(stderr, "workspace too small: %zu < %zu\n", ws_size, (size_t)WS_END);
    }
    Args a{};
    for (int i = 0; i < 17; ++i) a.in[i] = (const float*)d_in[i];
    a.out = (float*)d_out; a.ws = (unsigned char*)d_ws;
    (void)hipMemsetAsync((unsigned char*)d_ws + WS_BAR, 0, XCD_BAR_WORDS * 4, stream);
    void* args[] = {&a};
#ifdef PROBE_MASK
    a.mask = PROBE_MASK;
    (void)hipLaunchCooperativeKernel((const void*)mega, dim3(grid_blocks), dim3(NT), args, LDS_BYTES, stream);
    (void)hipMemsetAsync((unsigned char*)d_ws + WS_BAR, 0, XCD_BAR_WORDS * 4, stream);
#endif
    a.mask = 0x1fffu;
    hipError_t e = hipLaunchCooperativeKernel((const void*)mega, dim3(grid_blocks), dim3(NT), args, LDS_BYTES, stream);
    if (e != hipSuccess) fprintf(stderr, "cooperative launch failed: %s (grid %d)\n", hipGetErrorString(e), grid_blocks);
}
```

```cpp
#include <hip/hip_runtime.h>
#include <hip/hip_cooperative_groups.h>
#include <cstdio>
namespace cg = cooperative_groups;
namespace pg8 {
#define PG8_LAS __attribute__((address_space(3)))
typedef unsigned short bf16_t;
typedef short bf16x8 __attribute__((ext_vector_type(8)));
typedef float f32x4 __attribute__((ext_vector_type(4)));
typedef unsigned u32x4 __attribute__((ext_vector_type(4)));
constexpr int BM = 256, BK = 64, HALF = 128, HTB = HALF * BK * 2  , STAGE_BYTES = 8 * HTB, NXCD = 8, WGM = 8;

__host__ __device__ __forceinline__ int lds_byte(int r, int c) { const int st = (r >> 4) * 2 + (c >> 5), rr = r & 15, cc = c & 31, ob = rr * 64 + cc * 2; return st * 1024 + (ob ^ (((ob >> 9) & 1) << 5)); }
__host__ __device__ __forceinline__ void stage_rc(int b, int& R, int& C) { const int st = b / 1024, sb = b % 1024, swz = sb ^ (((sb >> 9) & 1) << 5); R = (st >> 1) * 16 + swz / 64; C = (st & 1) * 32 + (swz % 64) / 2; }
__host__ __device__ __forceinline__ int perm32(int rho) { const int n = rho >> 4, i = rho & 15; return 8 * (i >> 2) + 4 * n + (i & 3); }

struct Unit { int pm, pn; };
struct Gemm { const bf16_t* A; const bf16_t* Bt; int M, N, K; };
struct StaticOrder {
    int nM, nN, nwg, G, c;
    __host__ __device__ void init(int M, int N, int G_, int c_) { nM = M / BM; nN = N / BM; nwg = nM * nN; G = G_; c = c_; }
    __host__ __device__ bool next(int i, Unit& u) const {
        const long L = (long)i * G + c; if (L >= nwg) return false;
        int wgid = (int)L; { const int q = nwg / NXCD, r = nwg % NXCD, xcd = wgid % NXCD, off = wgid / NXCD; wgid = (xcd < r ? xcd * (q + 1) : r * (q + 1) + (xcd - r) * q) + off; }
        const int nig = WGM * nN, gid = wgid / nig, fm = gid * WGM, gsz = (nM - fm) < WGM ? (nM - fm) : WGM;
        u.pm = fm + ((wgid % nig) % gsz); u.pn = (wgid % nig) / gsz; return true;
    }
    __device__ __forceinline__ void a_ready(const Unit&) const {}
    __device__ __forceinline__ void done(const Unit&) const {}
};
__device__ __forceinline__ unsigned cvt_pk_bf16(float lo, float hi) { unsigned r; asm volatile("v_cvt_pk_bf16_f32 %0, %1, %2" : "=v"(r) : "v"(lo), "v"(hi)); return r; }
template <class Epi, class Sched, bool ALIGN_EPI = false, bool SP2 = false>
__device__ __forceinline__ void gemm_phase(PG8_LAS unsigned char* lds, const Gemm g, const Sched& S, const Epi& E) {
    const int tid = threadIdx.x, wid = __builtin_amdgcn_readfirstlane(tid >> 6), lane = tid & 63, wr = wid >> 2, wc = wid & 3, fr = lane & 15, fq = lane >> 4;
    const int K = g.K, nt = K / BK;
    unsigned voffA[2], voffB[2];
#pragma unroll
    for (int i = 0; i < 2; ++i) { int R, C; stage_rc(tid * 16 + i * 8192, R, C); const int Rb = Epi::PERM ? ((R & ~31) + perm32(R & 31)) : R;
        const int Ra = Epi::PERMA ? ((R & 64) + 4 * (R & 15) + ((R >> 4) & 3)) : R; voffA[i] = (unsigned)(Ra * K + C) * 2u; voffB[i] = (unsigned)(Rb * K + C) * 2u; }
    const size_t kstep = (size_t)(BK * 2);
    const size_t hstep = (size_t)HALF * K * 2;
    const size_t tstep = 2 * hstep;
    const unsigned ldsw = (unsigned)wid * 1024u;
    const int aoff = lds_byte(wr * 64 + fr, fq * 8), boff = lds_byte(wc * 32 + fr, fq * 8);
#define PG8_SA(b, h) (((b) * 2 + (h)) * HTB)
#define PG8_SB(b, h) ((4 + (b) * 2 + (h)) * HTB)
#define PG8_STAGE(bufoff, gbase, voff) do { _Pragma("unroll") for (int _i = 0; _i < 2; ++_i) \
        __builtin_amdgcn_global_load_lds((const unsigned*)((const char*)(gbase) + (voff)[_i]), (PG8_LAS unsigned*)(lds + (bufoff) + ldsw + _i * 8192), 16, 0, 0); } while (0)
#define PG8_LDA(dst, b, h) do { _Pragma("unroll") for (int m = 0; m < 4; ++m) _Pragma("unroll") for (int k = 0; k < 2; ++k) dst[m][k] = *(const PG8_LAS bf16x8*)(lds + PG8_SA(b, h) + aoff + m * 2048 + k * 1024); } while (0)
#define PG8_LDB(dst, b, h) do { _Pragma("unroll") for (int n = 0; n < 2; ++n) _Pragma("unroll") for (int k = 0; k < 2; ++k) dst[n][k] = *(const PG8_LAS bf16x8*)(lds + PG8_SB(b, h) + boff + n * 2048 + k * 1024); } while (0)
#define PG8_MMA(ai, bj, At, Bt) do { __builtin_amdgcn_s_setprio(1); _Pragma("unroll") for (int m = 0; m < 4; ++m) _Pragma("unroll") for (int n = 0; n < 2; ++n) _Pragma("unroll") for (int k = 0; k < 2; ++k) \
        acc[ai][bj][m][n] = __builtin_amdgcn_mfma_f32_16x16x32_bf16(Bt[n][k], At[m][k], acc[ai][bj][m][n], 0, 0, 0); __builtin_amdgcn_s_setprio(0); } while (0)
#define PG8_WAIT_V(n) asm volatile("s_waitcnt vmcnt(" #n ")" ::: "memory")
#define PG8_WAIT_L(n) asm volatile("s_waitcnt lgkmcnt(" #n ")" ::: "memory")
#define PG8_BAR __builtin_amdgcn_s_barrier()
#define PG8_SCHED __builtin_amdgcn_sched_barrier(0)
    Unit cur, nxt; int ui = 0;
    if (!S.next(0, cur)) return;
    f32x4 acc[2][2][4][2];
#pragma unroll
    for (int a = 0; a < 2; ++a)
#pragma unroll
        for (int b = 0; b < 2; ++b)
#pragma unroll
            for (int m = 0; m < 4; ++m)
#pragma unroll
                for (int n = 0; n < 2; ++n) acc[a][b][m][n] = (f32x4){0.f, 0.f, 0.f, 0.f};
    bf16x8 At[4][2], B0[2][2], B1[2][2];
    const char* cA = (const char*)g.A + (size_t)cur.pm * tstep; const char* cB = (const char*)g.Bt + (size_t)cur.pn * tstep;
    S.a_ready(cur);
    if constexpr (SP2) {
        PG8_STAGE(PG8_SB(0, 0), cB, voffB); PG8_STAGE(PG8_SB(0, 1), cB + hstep, voffB); PG8_STAGE(PG8_SA(0, 0), cA, voffA); PG8_STAGE(PG8_SA(0, 1), cA + hstep, voffA);
        if (wr == 1) PG8_BAR;
        PG8_WAIT_V(2); PG8_BAR;
        PG8_STAGE(PG8_SB(1, 0), cB + kstep, voffB); PG8_STAGE(PG8_SA(1, 0), cA + kstep, voffA); PG8_STAGE(PG8_SB(1, 1), cB + hstep + kstep, voffB);
        PG8_WAIT_V(6); PG8_BAR;
    } else {
        PG8_STAGE(PG8_SB(0, 0), cB, voffB); PG8_STAGE(PG8_SA(0, 0), cA, voffA); PG8_STAGE(PG8_SB(0, 1), cB + hstep, voffB); PG8_STAGE(PG8_SA(0, 1), cA + hstep, voffA);
        if (wr == 1) PG8_BAR;
        PG8_WAIT_V(4); PG8_BAR;
        PG8_STAGE(PG8_SB(1, 0), cB + kstep, voffB); PG8_STAGE(PG8_SA(1, 0), cA + kstep, voffA); PG8_STAGE(PG8_SB(1, 1), cB + hstep + kstep, voffB);
        PG8_WAIT_V(6); PG8_BAR;
    }
    for (;;) {
        const bool has_next = S.next(ui + 1, nxt);
        const char* nA = has_next ? (const char*)g.A + (size_t)nxt.pm * tstep : cA; const char* nB = has_next ? (const char*)g.Bt + (size_t)nxt.pn * tstep : cB;
        for (int t = 0; t < nt; t += 2) {
            const bool last = (t == nt - 2);
            const char* a1 = cA + (size_t)(t + 1) * kstep;
            const char* a2 = last ? nA : cA + (size_t)(t + 2) * kstep; const char* b2 = last ? nB : cB + (size_t)(t + 2) * kstep;
            const char* a3 = a2 + kstep; const char* b3 = b2 + kstep;
            if (last && has_next) S.a_ready(nxt);
            if constexpr (SP2) {
            PG8_LDB(B0, 0, 0); PG8_LDB(B1, 0, 1); PG8_SCHED; PG8_LDA(At, 0, 0); PG8_STAGE(PG8_SA(1, 1), a1 + hstep, voffA);
            PG8_WAIT_V(8); PG8_WAIT_L(0); PG8_BAR; PG8_MMA(0, 0, At, B0); PG8_MMA(0, 1, At, B1); PG8_BAR; PG8_SCHED;
            PG8_LDA(At, 0, 1); PG8_STAGE(PG8_SB(0, 0), b2, voffB); PG8_STAGE(PG8_SB(0, 1), b2 + hstep, voffB); PG8_STAGE(PG8_SA(0, 0), a2, voffA);
            PG8_WAIT_V(8); PG8_WAIT_L(0); PG8_BAR; PG8_MMA(1, 0, At, B0); PG8_MMA(1, 1, At, B1); PG8_BAR; PG8_SCHED;
            PG8_LDB(B0, 1, 0); PG8_LDB(B1, 1, 1); PG8_SCHED; PG8_LDA(At, 1, 0); PG8_STAGE(PG8_SA(0, 1), a2 + hstep, voffA);
            PG8_WAIT_V(8); PG8_WAIT_L(0); PG8_BAR; PG8_MMA(0, 0, At, B0); PG8_MMA(0, 1, At, B1); PG8_BAR; PG8_SCHED;
            PG8_LDA(At, 1, 1); PG8_STAGE(PG8_SB(1, 0), b3, voffB); PG8_STAGE(PG8_SB(1, 1), b3 + hstep, voffB); PG8_STAGE(PG8_SA(1, 0), a3, voffA);
            PG8_WAIT_V(8); PG8_WAIT_L(0); PG8_BAR; PG8_MMA(1, 0, At, B0); PG8_MMA(1, 1, At, B1); PG8_BAR; PG8_SCHED;
            } else {
            PG8_LDB(B0, 0, 0); PG8_SCHED; PG8_LDA(At, 0, 0); PG8_STAGE(PG8_SA(1, 1), a1 + hstep, voffA);
            PG8_WAIT_L(8); PG8_BAR; PG8_WAIT_L(0); PG8_MMA(0, 0, At, B0); PG8_BAR; PG8_SCHED;
            PG8_LDB(B1, 0, 1); PG8_STAGE(PG8_SB(0, 0), b2, voffB);
            PG8_BAR; PG8_WAIT_L(0); PG8_MMA(0, 1, At, B1); PG8_BAR;
            PG8_LDA(At, 0, 1); PG8_STAGE(PG8_SA(0, 0), a2, voffA);
            PG8_BAR; PG8_WAIT_L(0); PG8_MMA(1, 0, At, B0); PG8_BAR; PG8_SCHED;
            PG8_STAGE(PG8_SB(0, 1), b2 + hstep, voffB);
            PG8_WAIT_V(6); PG8_BAR; PG8_MMA(1, 1, At, B1); PG8_BAR;
            PG8_LDB(B0, 1, 0); PG8_SCHED; PG8_LDA(At, 1, 0); PG8_STAGE(PG8_SA(0, 1), a2 + hstep, voffA);
            PG8_WAIT_L(8); PG8_BAR; PG8_WAIT_L(0); PG8_MMA(0, 0, At, B0); PG8_BAR; PG8_SCHED;
            PG8_LDB(B1, 1, 1); PG8_STAGE(PG8_SB(1, 0), b3, voffB);
            PG8_BAR; PG8_WAIT_L(0); PG8_MMA(0, 1, At, B1); PG8_BAR;
            PG8_LDA(At, 1, 1); PG8_STAGE(PG8_SA(1, 0), a3, voffA);
            PG8_BAR; PG8_WAIT_L(0); PG8_MMA(1, 0, At, B0); PG8_BAR; PG8_SCHED;
            PG8_STAGE(PG8_SB(1, 1), b3 + hstep, voffB);
            PG8_WAIT_V(6); PG8_BAR; PG8_MMA(1, 1, At, B1); PG8_BAR;
            }
        }
        if constexpr (ALIGN_EPI) { if (wr == 0) PG8_BAR; }
        if constexpr (!Epi::AFTER_DRAIN) { E(acc, cur, wr, wc, fr, fq); S.done(cur); }
        if (!has_next) break;
#pragma unroll
        for (int a = 0; a < 2; ++a)
#pragma unroll
            for (int b = 0; b < 2; ++b)
#pragma unroll
                for (int m = 0; m < 4; ++m)
#pragma unroll
                    for (int n = 0; n < 2; ++n) acc[a][b][m][n] = (f32x4){0.f, 0.f, 0.f, 0.f};
        cur = nxt; cA = nA; cB = nB; ++ui;
        if constexpr (ALIGN_EPI) { if (wr == 1) PG8_BAR; }
    }
    PG8_WAIT_V(0);
    if constexpr (!ALIGN_EPI) { if (wr == 0) PG8_BAR; }
    PG8_BAR;
    if constexpr (Epi::AFTER_DRAIN) { E.fused(acc, cur, wr, wc, fr, fq, lds, wid, lane); S.done(cur); }
#undef PG8_SA
#undef PG8_SB
#undef PG8_STAGE
#undef PG8_LDA
#undef PG8_LDB
#undef PG8_MMA
#undef PG8_WAIT_V
#undef PG8_WAIT_L
#undef PG8_BAR
#undef PG8_SCHED
}
}

typedef pg8::bf16_t bf16_t;
typedef pg8::f32x4 f32x4;
typedef pg8::u32x4 u32x4;
typedef unsigned u32x2 __attribute__((ext_vector_type(2)));

constexpr int M = 32768, D = 1024, NPROJ = 2560, DFF = 2816, NUP = 5632;
constexpr float EPS = 1e-6f;
constexpr size_t MBY = 1048576;
constexpr size_t WS_WIN = 0, WS_WOUT = 5 * MBY, WS_WUP = 7 * MBY, WS_WDOWN = 18 * MBY, WS_BETA = 24 * MBY, WS_G = 24 * MBY + MBY / 2, WS_SS2 = 25 * MBY;
constexpr size_t WS_H1B = 32 * MBY, WS_MIX = 32 * MBY, WS_PROJ = 96 * MBY, WS_QB = 256 * MBY, WS_KB = 288 * MBY, WS_VB = 320 * MBY, WS_OF = 352 * MBY;
constexpr size_t WS_XB = 96 * MBY, WS_UPH = 160 * MBY, WS_ACT = 336 * MBY, WS_END = 512 * MBY;
constexpr size_t WS_KT = 32 * MBY, WS_VT = 64 * MBY, WS_RS1 = 27 * MBY + 262144;
constexpr int LDS_BYTES = 131072 + 256 + 8192, NT = 512;
constexpr size_t WS_BAR = 30 * MBY;

struct Args { const float* in[17]; float* out; unsigned char* ws; unsigned mask; unsigned pad; };

__device__ __forceinline__ float bf_lo(unsigned w) { return __uint_as_float(w << 16); }
__device__ __forceinline__ float bf_hi(unsigned w) { return __uint_as_float(w & 0xffff0000u); }
typedef float f32x2_ __attribute__((ext_vector_type(2)));
typedef __bf16 bf16x2_ __attribute__((ext_vector_type(2)));
__device__ __forceinline__ unsigned pk2(float a, float b) { return pg8::cvt_pk_bf16(a, b); }
__device__ __forceinline__ unsigned pk2c(float a, float b) { const f32x2_ v = {a, b}; const bf16x2_ r = __builtin_convertvector(v, bf16x2_); return __builtin_bit_cast(unsigned, r); }
__device__ __forceinline__ void unpack8(const u32x4 w, float (&f)[8]) { f[0] = bf_lo(w.x); f[1] = bf_hi(w.x); f[2] = bf_lo(w.y); f[3] = bf_hi(w.y); f[4] = bf_lo(w.z); f[5] = bf_hi(w.z); f[6] = bf_lo(w.w); f[7] = bf_hi(w.w); }
__device__ __forceinline__ u32x4 pack8(const float (&f)[8]) { u32x4 o; o.x = pk2(f[0], f[1]); o.y = pk2(f[2], f[3]); o.z = pk2(f[4], f[5]); o.w = pk2(f[6], f[7]); return o; }
__device__ __forceinline__ float wave_sum(float v) {
#pragma unroll
    for (int o = 1; o < 64; o <<= 1) v += __shfl_xor(v, o);
    return v;
}
template <int CTRL> __device__ __forceinline__ float dpp_mov(float x) { return __builtin_bit_cast(float, __builtin_amdgcn_update_dpp(0, __builtin_bit_cast(int, x), CTRL, 0xf, 0xf, true)); }
__device__ __forceinline__ float sum16(float v) {
    v += dpp_mov<0x128>(v); v += dpp_mov<0x124>(v); v += dpp_mov<0x122>(v); v += dpp_mov<0x121>(v);
    return v;
}
__device__ __forceinline__ float row_up1(float v) { return dpp_mov<0x111>(v); }
__device__ __forceinline__ float sigmoidf_(float x) { return __builtin_amdgcn_rcpf(1.0f + __builtin_amdgcn_exp2f(x * -1.4426950408889634f)); }
__device__ __forceinline__ float siluf_(float x) { return x * __builtin_amdgcn_rcpf(1.0f + __builtin_amdgcn_exp2f(x * -1.4426950408889634f)); }

struct EpiBf16Plain {
    static constexpr bool PERM = true, PERMA = false, AFTER_DRAIN = false;
    bf16_t* O; int ldc; const float* RS;
    __device__ __forceinline__ void operator()(const f32x4 (&acc)[2][2][4][2], const pg8::Unit& u, int wr, int wc, int fr, int fq) const {
        const int row0 = u.pm * 256 + wr * 64 + fr, col0 = u.pn * 256 + wc * 32 + 8 * fq;
        float rs[2][4];
#pragma unroll
        for (int ai = 0; ai < 2; ++ai)
#pragma unroll
            for (int m = 0; m < 4; ++m) rs[ai][m] = RS[row0 + ai * 128 + m * 16];
#pragma unroll
        for (int ai = 0; ai < 2; ++ai)
#pragma unroll
            for (int m = 0; m < 4; ++m) { bf16_t* rowp = O + (size_t)(row0 + ai * 128 + m * 16) * ldc + col0;
#pragma unroll
                for (int bj = 0; bj < 2; ++bj) { const f32x4 v0 = acc[ai][bj][m][0] * rs[ai][m], v1 = acc[ai][bj][m][1] * rs[ai][m];
                    u32x4 w; w.x = pk2(v0[0], v0[1]); w.y = pk2(v0[2], v0[3]); w.z = pk2(v1[0], v1[1]); w.w = pk2(v1[2], v1[3]);
                    *(u32x4*)(rowp + bj * 128) = w; } }
    }
};
struct EpiOutProj {
    static constexpr bool PERM = true, PERMA = false, AFTER_DRAIN = false;
    const bf16_t* X; bf16_t* XB; float* SS;
    __device__ __forceinline__ void operator()(f32x4 (&acc)[2][2][4][2], const pg8::Unit& u, int wr, int wc, int fr, int fq) const {
        const int row0 = u.pm * 256 + wr * 64 + fr, col0 = u.pn * 256 + wc * 32 + 8 * fq;
#pragma unroll
        for (int ai = 0; ai < 2; ++ai) {
            f32x4 rx[4][2][2];
#pragma unroll
            for (int m = 0; m < 4; ++m)
#pragma unroll
                for (int bj = 0; bj < 2; ++bj) { float f[8]; unpack8(*(const u32x4*)(X + (size_t)(row0 + ai * 128 + m * 16) * 1024 + col0 + bj * 128), f);
                    rx[m][bj][0] = (f32x4){f[0], f[1], f[2], f[3]}; rx[m][bj][1] = (f32x4){f[4], f[5], f[6], f[7]}; }
#pragma unroll
            for (int m = 0; m < 4; ++m) { const int row = row0 + ai * 128 + m * 16; float s = 0.f;
#pragma unroll
                for (int bj = 0; bj < 2; ++bj) { const f32x4 v0 = acc[ai][bj][m][0] + rx[m][bj][0], v1 = acc[ai][bj][m][1] + rx[m][bj][1];
                    s += (v0[0] * v0[0] + v0[1] * v0[1]) + (v0[2] * v0[2] + v0[3] * v0[3]) + (v1[0] * v1[0] + v1[1] * v1[1]) + (v1[2] * v1[2] + v1[3] * v1[3]);
                    u32x4 w; w.x = pk2(v0[0], v0[1]); w.y = pk2(v0[2], v0[3]); w.z = pk2(v1[0], v1[1]); w.w = pk2(v1[2], v1[3]);
                    *(u32x4*)(XB + (size_t)row * 1024 + col0 + bj * 128) = w; }
                s += __shfl_xor(s, 16); s += __shfl_xor(s, 32); if (fq == 0) SS[(size_t)row * 16 + u.pn * 4 + wc] = s; }
        }
    }
};
constexpr size_t WS_YB = 192 * MBY, WS_SS3 = 25 * MBY;
struct EpiDown {
    static constexpr bool PERM = true, PERMA = false, AFTER_DRAIN = false;
    const bf16_t* XB; bf16_t* YB; float* SS;
    __device__ __forceinline__ void operator()(f32x4 (&acc)[2][2][4][2], const pg8::Unit& u, int wr, int wc, int fr, int fq) const {
        const int row0 = u.pm * 256 + wr * 64 + fr, col0 = u.pn * 256 + wc * 32 + 8 * fq;
#pragma unroll
        for (int ai = 0; ai < 2; ++ai) {
            u32x4 rx[4][2];
#pragma unroll
            for (int m = 0; m < 4; ++m)
#pragma unroll
                for (int bj = 0; bj < 2; ++bj) rx[m][bj] = *(const u32x4*)(XB + (size_t)(row0 + ai * 128 + m * 16) * 1024 + col0 + bj * 128);
#pragma unroll
            for (int m = 0; m < 4; ++m) { const int row = row0 + ai * 128 + m * 16; float s = 0.f;
#pragma unroll
                for (int bj = 0; bj < 2; ++bj) { float f[8]; unpack8(rx[m][bj], f);
                    const f32x4 v0 = acc[ai][bj][m][0] + (f32x4){f[0], f[1], f[2], f[3]}, v1 = acc[ai][bj][m][1] + (f32x4){f[4], f[5], f[6], f[7]};
                    s += (v0[0] * v0[0] + v0[1] * v0[1]) + (v0[2] * v0[2] + v0[3] * v0[3]) + (v1[0] * v1[0] + v1[1] * v1[1]) + (v1[2] * v1[2] + v1[3] * v1[3]);
                    u32x4 w; w.x = pk2(v0[0], v0[1]); w.y = pk2(v0[2], v0[3]); w.z = pk2(v1[0], v1[1]); w.w = pk2(v1[2], v1[3]);
                    *(u32x4*)(YB + (size_t)row * 1024 + col0 + bj * 128) = w; }
                s += __shfl_xor(s, 16); s += __shfl_xor(s, 32); if (fq == 0) SS[(size_t)row * 16 + u.pn * 4 + wc] = s; }
        }
    }
};
struct EpiUpRaw {
    static constexpr bool PERM = true, PERMA = false, AFTER_DRAIN = false;
    bf16_t* O; const float* SS;
    __device__ __forceinline__ void operator()(const f32x4 (&acc)[2][2][4][2], const pg8::Unit& u, int wr, int wc, int fr, int fq) const {
        const int row0 = u.pm * 256 + wr * 64 + fr, col0 = u.pn * 256 + wc * 32 + 8 * fq;
#pragma unroll
        for (int ai = 0; ai < 2; ++ai)
#pragma unroll
            for (int m = 0; m < 4; ++m) { const int row = row0 + ai * 128 + m * 16;
                const f32x4 sv = *(const f32x4*)(SS + (size_t)row * 16 + 4 * fq); float s = (sv[0] + sv[1]) + (sv[2] + sv[3]); s += __shfl_xor(s, 16); s += __shfl_xor(s, 32);
                const float rstd = rsqrtf(s * (1.0f / 1024.0f) + EPS);
                bf16_t* rowp = O + (size_t)row * NUP + col0;
#pragma unroll
                for (int bj = 0; bj < 2; ++bj) { const f32x4 v0 = acc[ai][bj][m][0] * rstd, v1 = acc[ai][bj][m][1] * rstd;
                    u32x4 w; w.x = pk2(v0[0], v0[1]); w.y = pk2(v0[2], v0[3]); w.z = pk2(v1[0], v1[1]); w.w = pk2(v1[2], v1[3]);
                    *(u32x4*)(rowp + bj * 128) = w; } }
    }
};

constexpr size_t WS_HALO = 160 * MBY, WS_PWT = 28 * MBY;
struct EpiUpFused {
    static constexpr bool PERM = true, PERMA = true, AFTER_DRAIN = false;
    bf16_t* ACT; bf16_t* HALO; const float* SS; const float* FW; const float* FB; PG8_LAS unsigned char* WL;
    __device__ __forceinline__ void operator()(f32x4 (&acc)[2][2][4][2], const pg8::Unit& u, int wr, int wc, int fr, int fq) const {
        const int colj = u.pn * 128 + wc * 32 + 8 * fq;
        PG8_LAS unsigned char* wl = WL + (wr * 4 + wc) * 1024;
        {
            const int l = fq * 16 + fr, p = l >> 4, bj = (l >> 3) & 1, c4 = (l & 7) * 4;
            const float* srcp = (p < 3 ? FW + p * NUP : FB) + bj * DFF + u.pn * 128 + wc * 32 + c4;
            *(PG8_LAS f32x4*)(wl + l * 16) = *(const f32x4*)srcp;
        }
#pragma unroll
        for (int ai = 0; ai < 2; ++ai) {
            const int tb = u.pm * 256 + ai * 128 + wr * 64 + 4 * fr;
            float rstd[4];
#pragma unroll
            for (int m = 0; m < 4; ++m) { const f32x4 sv = *(const f32x4*)(SS + (size_t)(tb + m) * 16 + 4 * fq); float s = (sv[0] + sv[1]) + (sv[2] + sv[3]); s += __shfl_xor(s, 16); s += __shfl_xor(s, 32);
                rstd[m] = rsqrtf(s * (1.0f / 1024.0f) + EPS); }
            u32x2 pk[2][4];
#pragma unroll
            for (int n = 0; n < 2; ++n) {
                f32x4 g[4];
                {   const PG8_LAS unsigned char* wq = wl + (8 * fq + 4 * n) * 4;
                    const f32x4 w0 = *(const PG8_LAS f32x4*)(wq), w1 = *(const PG8_LAS f32x4*)(wq + 256), w2 = *(const PG8_LAS f32x4*)(wq + 512), bb = *(const PG8_LAS f32x4*)(wq + 768);
                    const f32x4 x0 = acc[ai][0][0][n] * rstd[0], x1 = acc[ai][0][1][n] * rstd[1], x2 = acc[ai][0][2][n] * rstd[2], x3 = acc[ai][0][3][n] * rstd[3];
                    acc[ai][0][0][n] = x0; acc[ai][0][1][n] = x1; acc[ai][0][2][n] = x2; acc[ai][0][3][n] = x3;
                    f32x4 p1, p2;
#pragma unroll
                    for (int c = 0; c < 4; ++c) { p1[c] = row_up1(x3[c]); p2[c] = row_up1(x2[c]); }
                    g[0] = bb + w2 * x0 + w1 * p1 + w0 * p2; g[1] = bb + w2 * x1 + w1 * x0 + w0 * p1;
                    g[2] = bb + w2 * x2 + w1 * x1 + w0 * x0; g[3] = bb + w2 * x3 + w1 * x2 + w0 * x1;
#pragma unroll
                    for (int m = 0; m < 4; ++m)
#pragma unroll
                        for (int c = 0; c < 4; ++c) g[m][c] = siluf_(g[m][c]);
                }
                __builtin_amdgcn_sched_barrier(0);
                {   const PG8_LAS unsigned char* wq = wl + 128 + (8 * fq + 4 * n) * 4;
                    const f32x4 w0 = *(const PG8_LAS f32x4*)(wq), w1 = *(const PG8_LAS f32x4*)(wq + 256), w2 = *(const PG8_LAS f32x4*)(wq + 512), bb = *(const PG8_LAS f32x4*)(wq + 768);
                    const f32x4 x0 = acc[ai][1][0][n] * rstd[0], x1 = acc[ai][1][1][n] * rstd[1], x2 = acc[ai][1][2][n] * rstd[2], x3 = acc[ai][1][3][n] * rstd[3];
                    acc[ai][1][0][n] = x0; acc[ai][1][1][n] = x1; acc[ai][1][2][n] = x2; acc[ai][1][3][n] = x3;
                    f32x4 p1, p2;
#pragma unroll
                    for (int c = 0; c < 4; ++c) { p1[c] = row_up1(x3[c]); p2[c] = row_up1(x2[c]); }
                    g[0] *= bb + w2 * x0 + w1 * p1 + w0 * p2; g[1] *= bb + w2 * x1 + w1 * x0 + w0 * p1;
                    g[2] *= bb + w2 * x2 + w1 * x1 + w0 * x0; g[3] *= bb + w2 * x3 + w1 * x2 + w0 * x1;
                }
#pragma unroll
                for (int m = 0; m < 4; ++m) { pk[n][m].x = pk2(g[m][0], g[m][1]); pk[n][m].y = pk2(g[m][2], g[m][3]); }
                __builtin_amdgcn_sched_barrier(0);
            }
#pragma unroll
            for (int m = 0; m < 4; ++m) if (fr != 0 || m >= 2) {
                u32x4 w; w.x = pk[0][m].x; w.y = pk[0][m].y; w.z = pk[1][m].x; w.w = pk[1][m].y;
                *(u32x4*)(ACT + (size_t)(tb + m) * DFF + colj) = w; }
            const int seg = u.pm * 4 + ai * 2 + wr;
            if (fr == 0 || fr == 15) {
#pragma unroll
                for (int mm = 0; mm < 2; ++mm) { const int m = (fr == 0) ? mm : 2 + mm;
#pragma unroll
                    for (int bj = 0; bj < 2; ++bj) { const f32x4 v0 = (fr == 0) ? acc[ai][bj][mm][0] : acc[ai][bj][2 + mm][0], v1 = (fr == 0) ? acc[ai][bj][mm][1] : acc[ai][bj][2 + mm][1];
                        u32x4 w; w.x = pk2(v0[0], v0[1]); w.y = pk2(v0[2], v0[3]); w.z = pk2(v1[0], v1[1]); w.w = pk2(v1[2], v1[3]);
                        *(u32x4*)(HALO + ((size_t)(seg * 4 + m) * 2 + bj) * DFF + colj) = w; } }
            }
        }
    }
};
__device__ __forceinline__ void phase_fixup(const Args& a) {
    const bf16_t* halo = (const bf16_t*)(a.ws + WS_HALO); bf16_t* act = (bf16_t*)(a.ws + WS_ACT);
    const float* fw = a.in[13]; const float* fb = a.in[14];
    const int total = 512 * 2 * 352;
    for (int it = blockIdx.x * NT + threadIdx.x; it < total; it += gridDim.x * NT) {
        const int p = it % 352, rs = it / 352, rho = rs & 1, seg = rs >> 1, j0 = p * 8; const bool first = (seg & 31) == 0; const size_t t = (size_t)seg * 64 + rho;
        float o[2][8];
#pragma unroll
        for (int bj = 0; bj < 2; ++bj) { const int col = bj * DFF + j0;
            float cur[8], m1[8], m2[8];
            unpack8(*(const u32x4*)(halo + ((size_t)(seg * 4 + rho) * 2 + bj) * DFF + j0), cur);
#pragma unroll
            for (int e = 0; e < 8; ++e) { m1[e] = 0.f; m2[e] = 0.f; }
            if (rho == 1) { unpack8(*(const u32x4*)(halo + ((size_t)(seg * 4 + 0) * 2 + bj) * DFF + j0), m1);
                if (!first) unpack8(*(const u32x4*)(halo + ((size_t)((seg - 1) * 4 + 3) * 2 + bj) * DFF + j0), m2); }
            else if (!first) { unpack8(*(const u32x4*)(halo + ((size_t)((seg - 1) * 4 + 3) * 2 + bj) * DFF + j0), m1);
                unpack8(*(const u32x4*)(halo + ((size_t)((seg - 1) * 4 + 2) * 2 + bj) * DFF + j0), m2); }
#pragma unroll
            for (int e = 0; e < 8; ++e) o[bj][e] = fb[col + e] + fw[2 * NUP + col + e] * cur[e] + fw[NUP + col + e] * m1[e] + fw[col + e] * m2[e];
        }
        float r8[8];
#pragma unroll
        for (int e = 0; e < 8; ++e) r8[e] = siluf_(o[0][e]) * o[1][e];
        *(u32x4*)(act + t * DFF + j0) = pack8(r8);
    }
}
#define GAS __attribute__((address_space(1)))
struct TileDesc { const float* W; bf16_t* WT; const float* ks; int ldw, K, k0, n0, src; };
constexpr int TW_IN = 8 * 40, TW_OUT = 8 * 16, TW_UP = 8 * 88, TW_DN = 22 * 16, TW_PW = 4 * 2;
constexpr int TW_A = TW_IN, TW_B = TW_A + TW_PW, TW_END = TW_B + TW_OUT + TW_UP + TW_DN;
__device__ __forceinline__ TileDesc tile_desc(const Args& a, int it) {
    TileDesc t; int r = it; t.ks = nullptr;
    if (r < TW_IN) { const int kb = r / 40, nb = r % 40, n0 = nb * 64; t.W = a.in[2]; t.ldw = 2568; t.WT = (bf16_t*)(a.ws + WS_WIN); t.K = 1024; t.k0 = kb * 128; t.n0 = n0; t.src = n0 < 2048 ? n0 : n0 + 8; t.ks = a.in[1]; return t; }
    r -= TW_IN;
    if (r < TW_PW) { const int kb = r / 2, nb = r % 2; t.W = a.in[7]; t.ldw = 128; t.WT = (bf16_t*)(a.ws + WS_PWT); t.K = 512; t.k0 = kb * 128; t.n0 = nb * 64; t.src = nb * 64; return t; }
    r -= TW_PW;
    if (r < TW_OUT) { const int kb = r / 16, nb = r % 16; t.W = a.in[10]; t.ldw = 1024; t.WT = (bf16_t*)(a.ws + WS_WOUT); t.K = 1024; t.k0 = kb * 128; t.n0 = nb * 64; t.src = nb * 64; return t; }
    r -= TW_OUT;
    if (r < TW_UP) { const int kb = r / 88, nb = r % 88, n0 = nb * 64, pn = n0 >> 8, rr = n0 & 255; t.W = a.in[12]; t.ldw = NUP; t.WT = (bf16_t*)(a.ws + WS_WUP); t.K = 1024; t.k0 = kb * 128; t.n0 = n0;
        t.src = (rr >> 7) * DFF + pn * 128 + (rr & 127); t.ks = a.in[11]; return t; }
    r -= TW_UP;
    { const int kb = r / 16, nb = r % 16; t.W = a.in[15]; t.ldw = 1024; t.WT = (bf16_t*)(a.ws + WS_WDOWN); t.K = DFF; t.k0 = kb * 128; t.n0 = nb * 64; t.src = nb * 64; return t; }
}
__device__ __forceinline__ void tile_load(const TileDesc& t, float (&v)[16]) {
    const int tid = threadIdx.x;
#pragma unroll
    for (int i = 0; i < 16; ++i) { const int kk = i * 8 + (tid >> 6), j = tid & 63; v[i] = t.W[(size_t)(t.k0 + kk) * t.ldw + t.src + j]; }
    if (t.ks) { float sc[16];
#pragma unroll
        for (int i = 0; i < 16; ++i) sc[i] = t.ks[t.k0 + i * 8 + (tid >> 6)];
#pragma unroll
        for (int i = 0; i < 16; ++i) v[i] *= sc[i]; }
}
__device__ __forceinline__ void phase_weights(const Args& a, PG8_LAS float* tile, int lo, int NTILES, int bid, int nb) {
    const int tid = threadIdx.x;
    int it = lo + bid; if (it >= NTILES) return;
    TileDesc cur = tile_desc(a, it); float v[16]; tile_load(cur, v);
    for (;;) {
#pragma unroll
        for (int i = 0; i < 16; ++i) tile[(i * 8 + (tid >> 6)) * 65 + (tid & 63)] = v[i];
        __syncthreads();
        const int nit = it + nb; const bool more = nit < NTILES; TileDesc nx = cur;
        if (more) { nx = tile_desc(a, nit); tile_load(nx, v); }
#pragma unroll
        for (int hh = 0; hh < 2; ++hh) { const int pidx = tid + 512 * hh, j = pidx >> 4, c = pidx & 15; const PG8_LAS float* s = tile + (8 * c) * 65 + j;
          u32x4 o; o.x = pk2(s[0], s[65]); o.y = pk2(s[130], s[195]); o.z = pk2(s[260], s[325]); o.w = pk2(s[390], s[455]);
          *(u32x4*)(cur.WT + (size_t)(cur.n0 + j) * cur.K + cur.k0 + 8 * c) = o; }
        __syncthreads();
        if (!more) break;
        cur = nx; it = nit;
    }
}
__device__ __forceinline__ void phase_norm1(const Args& a, float* wba) {
    const int tid = threadIdx.x, lane = tid & 63, wave = tid >> 6;
    const float* x = a.in[0]; const float* nw1 = a.in[1]; const float* w_in = a.in[2];
    bf16_t* h1b = (bf16_t*)a.out; float* rs1 = (float*)(a.ws + WS_RS1); float* betaB = (float*)(a.ws + WS_BETA); float* gB = (float*)(a.ws + WS_G);
    for (int k = tid; k < 1024; k += NT) { const float nw = nw1[k];
#pragma unroll
        for (int c = 0; c < 8; ++c) wba[c * 1024 + k] = w_in[(size_t)k * 2568 + 2048 + c] * nw; }
    __syncthreads();
    const int hh = (lane >> 3) & 3; const float alog = a.in[4][hh], dtb = a.in[5][hh]; const float aexp = -__expf(alog);
    f32x4 nwv[4];
#pragma unroll
    for (int j = 0; j < 4; ++j) nwv[j] = *(const f32x4*)(nw1 + 256 * j + 4 * lane);
    for (int row = blockIdx.x * 8 + wave; row < M; row += gridDim.x * 8) {
        const f32x4* xr = (const f32x4*)(x + (size_t)row * 1024) + lane;
        f32x4 v[4]; float ss = 0.f;
#pragma unroll
        for (int j = 0; j < 4; ++j) { v[j] = xr[64 * j]; ss += (v[j][0] * v[j][0] + v[j][1] * v[j][1]) + (v[j][2] * v[j][2] + v[j][3] * v[j][3]); }
        ss = wave_sum(ss); const float rstd = rsqrtf(ss * (1.0f / 1024.0f) + EPS);
        float d[8];
#pragma unroll
        for (int c = 0; c < 8; ++c) { float s = 0.f;
#pragma unroll
            for (int j = 0; j < 4; ++j) { const f32x4 w = *(const f32x4*)(wba + c * 1024 + 256 * j + 4 * lane); s += (v[j][0] * w[0] + v[j][1] * w[1]) + (v[j][2] * w[2] + v[j][3] * w[3]); }
            d[c] = s; }
        float dsum;
        { const bool b5 = lane & 32, b4 = lane & 16, b3 = lane & 8; float r4[4], r2[2];
#pragma unroll
          for (int i = 0; i < 4; ++i) { const float snd = b5 ? d[i] : d[4 + i], kp = b5 ? d[4 + i] : d[i]; r4[i] = kp + __shfl_xor(snd, 32); }
#pragma unroll
          for (int i = 0; i < 2; ++i) { const float snd = b4 ? r4[i] : r4[2 + i], kp = b4 ? r4[2 + i] : r4[i]; r2[i] = kp + __shfl_xor(snd, 16); }
          { const float snd = b3 ? r2[0] : r2[1], kp = b3 ? r2[1] : r2[0]; dsum = kp + __shfl_xor(snd, 8); }
          dsum += __shfl_xor(dsum, 4); dsum += __shfl_xor(dsum, 2); dsum += __shfl_xor(dsum, 1); dsum *= rstd; }
        bf16_t* hr = h1b + (size_t)row * 1024 + 4 * lane;
#pragma unroll
        for (int j = 0; j < 4; ++j) { const f32x4 h = v[j]; u32x2 w; w.x = pk2(h[0], h[1]); w.y = pk2(h[2], h[3]); *(u32x2*)(hr + 256 * j) = w; }
        if (lane == 0) rs1[row] = rstd;
        if ((lane & 7) == 0) { const int c = lane >> 3;
            if (c < 4) betaB[(size_t)row * 4 + c] = sigmoidf_(dsum);
            else { const float z = dsum + dtb; const float sp = z > 20.f ? z : log1pf(__expf(z)); gB[(size_t)row * 4 + (c - 4)] = aexp * sp; } }
    }
}

__device__ __forceinline__ void phase_qkv(const Args& a) {
    const int tid = threadIdx.x, lane = tid & 63, wave = tid >> 6;
    const bf16_t* proj = (const bf16_t*)(a.ws + WS_PROJ); const float* cw = a.in[3];
    for (int item = blockIdx.x * 8 + wave; item < 6144; item += gridDim.x * 8) {
        const int part = item % 3, rg = item / 3, rowA = rg * 16, pos0 = rowA & 2047, ch0 = part * 512 + 8 * lane;
        float w[4][8];
#pragma unroll
        for (int i = 0; i < 4; ++i) { const f32x4 w0 = *(const f32x4*)(cw + i * 1536 + ch0), w1 = *(const f32x4*)(cw + i * 1536 + ch0 + 4);
            w[i][0] = w0[0]; w[i][1] = w0[1]; w[i][2] = w0[2]; w[i][3] = w0[3]; w[i][4] = w1[0]; w[i][5] = w1[1]; w[i][6] = w1[2]; w[i][7] = w1[3]; }
        u32x4 R[19];
#pragma unroll
        for (int j = 0; j < 19; ++j) { const int dr = j - 3; const int rr = (pos0 + dr >= 0) ? rowA + dr : rowA; R[j] = *(const u32x4*)(proj + (size_t)rr * NPROJ + ch0); }
        bf16_t* dst = (bf16_t*)(a.ws + (part == 0 ? WS_QB : WS_KB)) + (size_t)rowA * 512 + 8 * lane;
        const float qsc = (part == 0) ? 0.08838834764831845f : 1.0f;
        u32x4 yb[16]; float F[19][8];
#pragma unroll
        for (int m = 0; m < 16; ++m) {
            float acc[8];
#pragma unroll
            for (int e = 0; e < 8; ++e) acc[e] = 0.f;
            if (m == 0) { unpack8(R[0], F[0]); unpack8(R[1], F[1]); unpack8(R[2], F[2]); }
            unpack8(R[m + 3], F[m + 3]);
#pragma unroll
            for (int i = 0; i < 4; ++i) {
                if (m + i < 3) { const float vm = (pos0 + m + i - 3 >= 0) ? 1.0f : 0.0f;
#pragma unroll
                    for (int e = 0; e < 8; ++e) acc[e] += F[m + i][e] * (w[i][e] * vm); }
                else {
#pragma unroll
                    for (int e = 0; e < 8; ++e) acc[e] += F[m + i][e] * w[i][e]; } }
            float ssq = 0.f;
#pragma unroll
            for (int e = 0; e < 8; ++e) { acc[e] = siluf_(acc[e]); ssq += acc[e] * acc[e]; }
            if (part < 2) { ssq = sum16(ssq); const float sc = rsqrtf(ssq + EPS) * qsc;
#pragma unroll
                for (int e = 0; e < 8; ++e) acc[e] *= sc; }
            yb[m] = pack8(acc);
            if (part < 2) *(u32x4*)(dst + (size_t)m * 512) = yb[m];
        }
        if (part > 0) {
            bf16_t* tb = (bf16_t*)(a.ws + (part == 1 ? WS_KT : WS_VT)) + ((size_t)(rg >> 2) * 512 + 8 * lane) * 64 + (rg & 3) * 16;
#pragma unroll
            for (int e = 0; e < 8; ++e) { u32x4 o0, o1;
#pragma unroll
                for (int pp = 0; pp < 8; ++pp) { const unsigned A = yb[2 * pp][e >> 1], B = yb[2 * pp + 1][e >> 1];
                    const unsigned v = (e & 1) ? ((A >> 16) | (B & 0xffff0000u)) : ((A & 0xffffu) | (B << 16));
                    if (pp < 4) o0[pp] = v; else o1[pp - 4] = v; }
                *(u32x4*)(tb + e * 64) = o0; *(u32x4*)(tb + e * 64 + 8) = o1; }
        }
    }
}
typedef pg8::bf16x8 bf16x8;
#define MFMA16(a, b, c) __builtin_amdgcn_mfma_f32_16x16x32_bf16((a), (b), (c), 0, 0, 0)
constexpr size_t WS_GL = 27 * MBY, WS_PREP = 352 * MBY, WS_OF2 = 256 * MBY;
constexpr int PREP_ITEM = 73728, PI_W = 0, PI_QG = 16384, PI_KD = 32768, PI_UT = 49152, PI_AQ = 65536;
__host__ __device__ __forceinline__ constexpr int perm32s(int o) { return 8 * ((o >> 2) & 3) + 4 * (o >> 4) + (o & 3); }
__host__ __device__ __forceinline__ constexpr int tokofpos(int p) { return (p & 32) + 16 * ((p & 7) >> 2) + 4 * ((p >> 3) & 3) + (p & 3); }
__device__ __forceinline__ bf16x8 packf8(const f32x4 lo, const f32x4 hi) { u32x4 p; p.x = pk2(lo[0], lo[1]); p.y = pk2(lo[2], lo[3]); p.z = pk2(hi[0], hi[1]); p.w = pk2(hi[2], hi[3]); return __builtin_bit_cast(bf16x8, p); }
__device__ __forceinline__ bf16_t f2bf(float x) { return (bf16_t)(pk2(x, x) & 0xffffu); }
__device__ __forceinline__ float bf2f(bf16_t x) { return __uint_as_float(((unsigned)x) << 16); }

__device__ __forceinline__ void solve64(float (&x)[64], const PG8_LAS float* sLt) {
    f32x4 cur[16];
#pragma unroll
    for (int i4 = 0; i4 < 16; ++i4) cur[i4] = *(const PG8_LAS f32x4*)(sLt + 4 * i4);
    asm volatile("" ::: "memory");
#pragma unroll
    for (int j = 0; j < 63; ++j) {
        const float xj = x[j];
#pragma unroll
        for (int i4 = (j + 1) / 4; i4 < 16; ++i4) {
            if (4 * i4 + 0 > j) x[4 * i4 + 0] -= cur[i4][0] * xj;
            if (4 * i4 + 1 > j) x[4 * i4 + 1] -= cur[i4][1] * xj;
            if (4 * i4 + 2 > j) x[4 * i4 + 2] -= cur[i4][2] * xj;
            if (4 * i4 + 3 > j) x[4 * i4 + 3] -= cur[i4][3] * xj;
            if (j + 1 < 63 && i4 >= (j + 2) / 4) cur[i4] = *(const PG8_LAS f32x4*)(sLt + (j + 1) * 64 + 4 * i4); }
        asm volatile("" ::: "memory");
    }
}

__device__ __forceinline__ void phase_prep(const Args& a, PG8_LAS unsigned char* lds) {
    const int tid = threadIdx.x, lane = tid & 63, wave = __builtin_amdgcn_readfirstlane(tid >> 6), half = wave >> 2, lw = wave & 3, q = lane >> 4, r = lane & 15;
    const int role = (lw - half) & 3;
    PG8_LAS unsigned char* hb = lds + half * 36864;
    PG8_LAS float* sG = (PG8_LAS float*)hb; PG8_LAS float* sB = sG + 64; PG8_LAS float* sE = sG + 128; PG8_LAS float* sK = sG + 192; PG8_LAS float* sL = sG + 256;
    PG8_LAS unsigned char* Tu = hb + 17408; PG8_LAS unsigned char* Tw = Tu + 9216;
    const bf16_t* qb = (const bf16_t*)(a.ws + WS_QB); const bf16_t* kb = (const bf16_t*)(a.ws + WS_KB);
    const bf16_t* kT = (const bf16_t*)(a.ws + WS_KT); const bf16_t* vT = (const bf16_t*)(a.ws + WS_VT);
    const float* betaB = (const float*)(a.ws + WS_BETA); const float* gB = (const float*)(a.ws + WS_G); float* glast = (float*)(a.ws + WS_GL);
    for (int unit = blockIdx.x; unit < 1024; unit += gridDim.x) {
        const int hp = unit & 1, bn = unit >> 1, h = 2 * hp + half, item = bn * 4 + h; const size_t r0 = (size_t)bn * 64;
        unsigned char* pi = a.ws + WS_PREP + (size_t)item * PREP_ITEM;
        bf16_t* wp = (bf16_t*)(pi + PI_W); bf16_t* qgp = (bf16_t*)(pi + PI_QG); bf16_t* kdTp = (bf16_t*)(pi + PI_KD); bf16_t* uT = (bf16_t*)(pi + PI_UT); bf16_t* aqkp = (bf16_t*)(pi + PI_AQ);
        const bf16_t* qbase = qb + r0 * 512 + h * 128; const bf16_t* kbase = kb + r0 * 512 + h * 128;
        const bf16_t* kTb = kT + ((size_t)bn * 512 + h * 128) * 64; const bf16_t* vTb = vT + ((size_t)bn * 512 + h * 128) * 64;
        bf16x8 ak[4], aq[4], bkf[2][4];
#pragma unroll
        for (int s = 0; s < 4; ++s) { ak[s] = *(const bf16x8*)(kbase + (size_t)(16 * lw + r) * 512 + 32 * s + 8 * q); aq[s] = *(const bf16x8*)(qbase + (size_t)(16 * lw + r) * 512 + 32 * s + 8 * q); }
#pragma unroll
        for (int tj = 0; tj < 2; ++tj)
#pragma unroll
            for (int s = 0; s < 4; ++s) bkf[tj][s] = *(const bf16x8*)(kbase + (size_t)(16 * tj + r) * 512 + 32 * s + 8 * q);
        bf16x8 pv[2][2], pk[2][2];
        if (role != 0) {
#pragma unroll
        for (int cc = 0; cc < 2; ++cc) { const int ct = 2 * lw + cc;
            pv[cc][0] = *(const bf16x8*)(vTb + (size_t)(16 * ct + r) * 64 + 8 * q); pv[cc][1] = *(const bf16x8*)(vTb + (size_t)(16 * ct + r) * 64 + 32 + 8 * q);
            pk[cc][0] = *(const bf16x8*)(kTb + (size_t)(16 * ct + r) * 64 + 8 * q); pk[cc][1] = *(const bf16x8*)(kTb + (size_t)(16 * ct + r) * 64 + 32 + 8 * q); } }
        float gv = gB[(r0 + lane) * 4 + h];
#pragma unroll
        for (int off = 1; off < 64; off <<= 1) { const float t = __shfl_up(gv, off); if (lane >= off) gv += t; }
        const float g63 = __shfl(gv, 63);
        if (lw == 0) { sG[lane] = gv; sB[lane] = betaB[(r0 + lane) * 4 + h]; sE[lane] = __expf(gv); sK[lane] = __expf(g63 - gv); }
        if ((tid & 255) == 0) glast[item] = __expf(g63);
        __syncthreads();
        {
#pragma unroll
            for (int tj = 0; tj < 4; ++tj) {
                f32x4 ckk = {0.f, 0.f, 0.f, 0.f}, cqk = {0.f, 0.f, 0.f, 0.f};
#pragma unroll
                for (int s = 0; s < 4; ++s) { const bf16x8 bk = (tj < 2) ? bkf[tj & 1][s] : *(const bf16x8*)(kbase + (size_t)(16 * tj + r) * 512 + 32 * s + 8 * q); ckk = MFMA16(ak[s], bk, ckk); cqk = MFMA16(aq[s], bk, cqk); }
                const int j = 16 * tj + r; const float Gj = sG[j]; const int jpos = (j & 32) + perm32s(j & 31);
                f32x4 lv;
#pragma unroll
                for (int e = 0; e < 4; ++e) { const int i = 16 * lw + 4 * q + e; const float Gi = sG[i], bi = sB[i];
                    const float dec = (i >= j) ? __expf(Gi - Gj) : 0.f;
                    lv[e] = (i > j) ? ckk[e] * bi * dec : 0.f;
                    aqkp[i * 64 + jpos] = f2bf((i >= j) ? cqk[e] * dec : 0.f); }
                *(PG8_LAS f32x4*)(sL + j * 64 + 16 * lw + 4 * q) = lv;
            }
        }
        __syncthreads();
        if (role == 0) {
            float x[64];
#pragma unroll
            for (int i = 0; i < 64; ++i) x[i] = (i == lane) ? 1.0f : 0.0f;
            __builtin_amdgcn_s_setprio(3);
            solve64(x, sL);
            __builtin_amdgcn_s_setprio(0);
#pragma unroll
            for (int cc = 0; cc < 2; ++cc) { const int ct = 2 * lw + cc;
                pv[cc][0] = *(const bf16x8*)(vTb + (size_t)(16 * ct + r) * 64 + 8 * q); pv[cc][1] = *(const bf16x8*)(vTb + (size_t)(16 * ct + r) * 64 + 32 + 8 * q);
                pk[cc][0] = *(const bf16x8*)(kTb + (size_t)(16 * ct + r) * 64 + 8 * q); pk[cc][1] = *(const bf16x8*)(kTb + (size_t)(16 * ct + r) * 64 + 32 + 8 * q); }
            const float bj = sB[lane], bej = bj * sE[lane];
#pragma unroll
            for (int i = 0; i < 64; ++i) { *(PG8_LAS bf16_t*)(Tu + (i * 72 + lane) * 2) = f2bf(x[i] * bj); *(PG8_LAS bf16_t*)(Tw + (i * 72 + lane) * 2) = f2bf(x[i] * bej); }
        } else if (role == 1) {
#pragma unroll 4
            for (int k = 0; k < 16; ++k) { const int pidx = lane + 64 * k, i = pidx >> 4, pc = pidx & 15, aa = pc & 3, c32 = (pc >> 2) * 32;
                float f[8]; unpack8(*(const u32x4*)(qbase + (size_t)i * 512 + pc * 8), f); const float e = sE[i];
                u32x2 lo, hi; lo.x = pk2(f[0] * e, f[1] * e); lo.y = pk2(f[2] * e, f[3] * e); hi.x = pk2(f[4] * e, f[5] * e); hi.y = pk2(f[6] * e, f[7] * e);
                *(u32x2*)(qgp + i * 128 + c32 + 8 * ((2 * aa) & 3) + 4 * (aa >> 1)) = lo;
                *(u32x2*)(qgp + i * 128 + c32 + 8 * ((2 * aa + 1) & 3) + 4 * (aa >> 1)) = hi; }
        } else {
            const int d = (role - 2) * 64 + lane; float x[64];
#pragma unroll
            for (int c8 = 0; c8 < 8; ++c8) { float f[8]; unpack8(*(const u32x4*)(kTb + (size_t)d * 64 + 8 * c8), f);
#pragma unroll
                for (int e = 0; e < 8; ++e) x[8 * c8 + e] = f[e] * sK[8 * c8 + e]; }
#pragma unroll
            for (int c8 = 0; c8 < 8; ++c8) { u32x4 o;
                o.x = pk2(x[tokofpos(8 * c8 + 0)], x[tokofpos(8 * c8 + 1)]); o.y = pk2(x[tokofpos(8 * c8 + 2)], x[tokofpos(8 * c8 + 3)]);
                o.z = pk2(x[tokofpos(8 * c8 + 4)], x[tokofpos(8 * c8 + 5)]); o.w = pk2(x[tokofpos(8 * c8 + 6)], x[tokofpos(8 * c8 + 7)]);
                *(u32x4*)(kdTp + d * 64 + 8 * c8) = o; }
        }
        __syncthreads();
        {
            bf16x8 tf[4][2];
#pragma unroll
            for (int it = 0; it < 4; ++it)
#pragma unroll
                for (int s = 0; s < 2; ++s) tf[it][s] = *(const PG8_LAS bf16x8*)(Tu + ((16 * it + r) * 72 + 32 * s + 8 * q) * 2);
#pragma unroll
            for (int cc = 0; cc < 2; ++cc) { const int ct = 2 * lw + cc;
                const bf16x8 v0 = pv[cc][0], v1 = pv[cc][1];
#pragma unroll
                for (int it = 0; it < 4; ++it) { f32x4 acc = {0.f, 0.f, 0.f, 0.f}; acc = MFMA16(tf[it][0], v0, acc); acc = MFMA16(tf[it][1], v1, acc);
                    u32x2 w; w.x = pk2c(acc[0], acc[1]); w.y = pk2c(acc[2], acc[3]);
                    *(u32x2*)(uT + (16 * ct + r) * 64 + 16 * it + 4 * q) = w; } }
#pragma unroll
            for (int it = 0; it < 4; ++it)
#pragma unroll
                for (int s = 0; s < 2; ++s) tf[it][s] = *(const PG8_LAS bf16x8*)(Tw + ((16 * it + r) * 72 + 32 * s + 8 * q) * 2);
#pragma unroll
            for (int cc = 0; cc < 2; ++cc) { const int dt = 2 * lw + cc;
                const bf16x8 k0 = pk[cc][0], k1 = pk[cc][1];
                const int o4 = 16 * dt + 4 * q, dpos = (o4 & ~31) + perm32s(o4 & 31);
#pragma unroll
                for (int it = 0; it < 4; ++it) { f32x4 acc = {0.f, 0.f, 0.f, 0.f}; acc = MFMA16(k0, tf[it][0], acc); acc = MFMA16(k1, tf[it][1], acc);
                    u32x2 w; w.x = pk2c(acc[0], acc[1]); w.y = pk2c(acc[2], acc[3]);
                    *(u32x2*)(wp + (16 * it + r) * 128 + dpos) = w; } }
        }
        __syncthreads();
    }
}

__device__ __forceinline__ void phase_scan(const Args& a, PG8_LAS unsigned char* lds, int sblk) {
    const int tid = threadIdx.x, lane = tid & 63, wave = tid >> 6, q = lane >> 4, r = lane & 15;
    const int bh = sblk >> 1, dvh = sblk & 1, b = bh >> 2, h = bh & 3;
    bf16_t* of = (bf16_t*)(a.ws + WS_OF2); const float* glast = (const float*)(a.ws + WS_GL);
    constexpr int L_W = 0, L_QG = 17408, L_KD = 34816, L_UT = 53248, L_AQ = 71680;
    f32x4 S[8];
#pragma unroll
    for (int m = 0; m < 8; ++m) S[m] = (f32x4){0.f, 0.f, 0.f, 0.f};
    u32x4 pre[9];
    { const unsigned char* src = a.ws + WS_PREP + (size_t)((b * 32 + 0) * 4 + h) * PREP_ITEM;
#pragma unroll
      for (int i = 0; i < 9; ++i) pre[i] = __builtin_nontemporal_load((const u32x4*)(src + (size_t)(tid + 512 * i) * 16)); }
    for (int n = 0; n < 32; ++n) {
#pragma unroll
        for (int i = 0; i < 9; ++i) { const int p = tid + 512 * i; int off;
            if (i < 2) off = L_W + (p >> 4) * 272 + (p & 15) * 16;
            else if (i < 4) { const int pp = p - 1024; off = L_QG + (pp >> 4) * 272 + (pp & 15) * 16; }
            else if (i < 6) { const int pp = p - 2048; off = L_KD + (pp >> 3) * 144 + (pp & 7) * 16; }
            else if (i < 8) { const int pp = p - 3072; off = L_UT + (pp >> 3) * 144 + (pp & 7) * 16; }
            else { const int pp = p - 4096; off = L_AQ + (pp >> 3) * 144 + (pp & 7) * 16; }
            *(PG8_LAS u32x4*)(lds + off) = pre[i]; }
        __syncthreads();
        if (n + 1 < 32) { const unsigned char* src = a.ws + WS_PREP + (size_t)((b * 32 + n + 1) * 4 + h) * PREP_ITEM;
#pragma unroll
            for (int i = 0; i < 9; ++i) pre[i] = __builtin_nontemporal_load((const u32x4*)(src + (size_t)(tid + 512 * i) * 16)); }
        if (wave < 4) {
            __builtin_amdgcn_s_setprio(2);
            const int dv0 = dvh * 64 + wave * 16; const float gl = glast[(b * 32 + n) * 4 + h]; const size_t row0 = (size_t)b * 2048 + n * 64;
            bf16x8 Sb[4];
#pragma unroll
            for (int s = 0; s < 4; ++s) Sb[s] = packf8(S[2 * s], S[2 * s + 1]);
            f32x4 vn[4];
#pragma unroll
            for (int mt = 0; mt < 4; ++mt) {
                const u32x2 uu = *(const PG8_LAS u32x2*)(lds + L_UT + (dv0 + r) * 144 + (16 * mt + 4 * q) * 2);
                f32x4 acc = {0.f, 0.f, 0.f, 0.f};
#pragma unroll
                for (int s = 0; s < 4; ++s) { const bf16x8 af = *(const PG8_LAS bf16x8*)(lds + L_W + (16 * mt + r) * 272 + (32 * s + 8 * q) * 2); acc = MFMA16(af, Sb[s], acc); }
                vn[mt] = (f32x4){bf_lo(uu.x), bf_hi(uu.x), bf_lo(uu.y), bf_hi(uu.y)} - acc;
            }
            bf16x8 Vb[2];
#pragma unroll
            for (int s = 0; s < 2; ++s) Vb[s] = packf8(vn[2 * s], vn[2 * s + 1]);
#pragma unroll
            for (int mt = 0; mt < 4; ++mt) {
                f32x4 o = {0.f, 0.f, 0.f, 0.f};
#pragma unroll
                for (int s = 0; s < 4; ++s) { const bf16x8 af = *(const PG8_LAS bf16x8*)(lds + L_QG + (16 * mt + r) * 272 + (32 * s + 8 * q) * 2); o = MFMA16(af, Sb[s], o); }
#pragma unroll
                for (int s = 0; s < 2; ++s) { const bf16x8 af = *(const PG8_LAS bf16x8*)(lds + L_AQ + (16 * mt + r) * 144 + (32 * s + 8 * q) * 2); o = MFMA16(af, Vb[s], o); }
#pragma unroll
                for (int e = 0; e < 4; ++e) of[(row0 + 16 * mt + 4 * q + e) * 512 + h * 128 + dv0 + r] = (bf16_t)(pk2c(o[e], o[e]) & 0xffffu);
            }
#pragma unroll
            for (int mt = 0; mt < 8; ++mt) {
                f32x4 acc = S[mt] * gl;
#pragma unroll
                for (int s = 0; s < 2; ++s) { const bf16x8 af = *(const PG8_LAS bf16x8*)(lds + L_KD + (16 * mt + r) * 144 + (32 * s + 8 * q) * 2); acc = MFMA16(af, Vb[s], acc); }
                S[mt] = acc;
            }
            __builtin_amdgcn_s_setprio(0);
        }
        __syncthreads();
    }
}
template <int WIN>
__device__ __forceinline__ void pool_fill(const bf16_t* proj, PG8_LAS unsigned char* lds, int row0, int gi) {
    const int tid = threadIdx.x, pc = tid & 15, tr = tid >> 4, tok0 = 4 * tr, rowA = row0 + tok0, pos0 = rowA & 2047;
    constexpr int NR = WIN + 3;
    u32x4 R[NR];
    const bf16_t* base = proj + 2048 + gi * 128 + pc * 8;
#pragma unroll
    for (int j = 0; j < NR; ++j) { const int dr = j - (WIN - 1); const int rr = (pos0 + dr >= 0) ? rowA + dr : rowA; R[j] = *(const u32x4*)(base + (size_t)rr * NPROJ); }
    float s[8];
#pragma unroll
    for (int e = 0; e < 8; ++e) s[e] = 0.f;
#pragma unroll
    for (int j = 0; j < WIN; ++j) { float f[8]; unpack8(R[j], f); const float vm = (pos0 + j - (WIN - 1) >= 0) ? 1.0f : 0.0f;
#pragma unroll
        for (int e = 0; e < 8; ++e) s[e] += vm * f[e]; }
#pragma unroll
    for (int m = 0; m < 4; ++m) {
        float u[8]; unpack8(R[WIN - 1 + m], u);
        if (m > 0) { float o[8]; unpack8(R[m - 1], o); const float vm = (pos0 + m - WIN >= 0) ? 1.0f : 0.0f;
#pragma unroll
            for (int e = 0; e < 8; ++e) s[e] += u[e] - vm * o[e]; }
        const int n = (pos0 + m + 1) < WIN ? (pos0 + m + 1) : WIN; const float inv = 1.0f / (float)n; float d[8];
#pragma unroll
        for (int e = 0; e < 8; ++e) d[e] = s[e] * inv - u[e];
        *(PG8_LAS u32x4*)(lds + (tok0 + m) * 272 + pc * 16) = pack8(d);
    }
}
__device__ __forceinline__ void phase_pool(const Args& a, PG8_LAS unsigned char* lds, int bid, int nb) {
    const int tid = threadIdx.x, lane = tid & 63, wave = tid >> 6, q = lane >> 4, r = lane & 15;
    const bf16_t* proj = (const bf16_t*)(a.ws + WS_PROJ); bf16_t* mix = (bf16_t*)(a.ws + WS_MIX); const bf16_t* pwt = (const bf16_t*)(a.ws + WS_PWT);
    const int gi = bid & 3;
    constexpr int L_WT = 34816, L_PB = L_WT + 128 * 272;
#pragma unroll
    for (int k = 0; k < 4; ++k) { const int idx = tid + 512 * k, row = idx >> 4, pc = idx & 15;
        *(PG8_LAS u32x4*)(lds + L_WT + row * 272 + pc * 16) = *(const u32x4*)(pwt + (size_t)row * 512 + gi * 128 + pc * 8); }
    if (tid < 128) { ((PG8_LAS float*)(lds + L_PB))[tid] = a.in[8][gi * 128 + tid]; ((PG8_LAS float*)(lds + L_PB))[128 + tid] = a.in[9][gi * 128 + tid]; }
    __syncthreads();
    for (int item = bid; item < 1024; item += nb) {
        const int tile = item >> 2, row0 = tile * 128;
        if (gi == 0) pool_fill<2>(proj, lds, row0, 0); else if (gi == 1) pool_fill<4>(proj, lds, row0, 1); else if (gi == 2) pool_fill<8>(proj, lds, row0, 2); else pool_fill<16>(proj, lds, row0, 3);
        __syncthreads();
        { bf16x8 df[4];
#pragma unroll
          for (int s = 0; s < 4; ++s) df[s] = *(const PG8_LAS bf16x8*)(lds + (16 * wave + r) * 272 + (32 * s + 8 * q) * 2);
#pragma unroll
          for (int nt = 0; nt < 8; ++nt) { f32x4 acc = {0.f, 0.f, 0.f, 0.f};
#pragma unroll
              for (int s = 0; s < 4; ++s) { const bf16x8 wf = *(const PG8_LAS bf16x8*)(lds + L_WT + (16 * nt + r) * 272 + (32 * s + 8 * q) * 2); acc = MFMA16(wf, df[s], acc); }
              const int dl = 16 * nt + 4 * q; const f32x4 o = (acc + *(const PG8_LAS f32x4*)(lds + L_PB + dl * 4)) * *(const PG8_LAS f32x4*)(lds + L_PB + 512 + dl * 4);
              u32x2 w; w.x = pk2(o[0], o[1]); w.y = pk2(o[2], o[3]);
              *(u32x2*)(mix + (size_t)(row0 + 16 * wave + r) * 1024 + 512 + gi * 128 + dl) = w; } }
        __syncthreads();
    }
}
__device__ __forceinline__ void phase_gate(const Args& a) {
    const int tid = threadIdx.x, lane = tid & 63, wave = tid >> 6;
    const bf16_t* proj = (const bf16_t*)(a.ws + WS_PROJ); const bf16_t* of = (const bf16_t*)(a.ws + WS_OF2); bf16_t* mix = (bf16_t*)(a.ws + WS_MIX);
    const float* onw = a.in[6]; const int c0 = (8 * lane) & 127;
    const f32x4 w0 = *(const f32x4*)(onw + c0), w1 = *(const f32x4*)(onw + c0 + 4);
    for (int row = blockIdx.x * 8 + wave; row < M; row += gridDim.x * 8) {
        float of8[8]; unpack8(*(const u32x4*)(of + (size_t)row * 512 + 8 * lane), of8);
        const f32x4 o0 = {of8[0], of8[1], of8[2], of8[3]}, o1 = {of8[4], of8[5], of8[6], of8[7]};
        float ss = (o0[0] * o0[0] + o0[1] * o0[1]) + (o0[2] * o0[2] + o0[3] * o0[3]) + (o1[0] * o1[0] + o1[1] * o1[1]) + (o1[2] * o1[2] + o1[3] * o1[3]);
        ss = sum16(ss); const float r = rsqrtf(ss * (1.0f / 128.0f) + EPS);
        float z[8]; unpack8(*(const u32x4*)(proj + (size_t)row * NPROJ + 1536 + 8 * lane), z);
        float y[8];
        y[0] = o0[0] * r * w0[0] * siluf_(z[0]); y[1] = o0[1] * r * w0[1] * siluf_(z[1]); y[2] = o0[2] * r * w0[2] * siluf_(z[2]); y[3] = o0[3] * r * w0[3] * siluf_(z[3]);
        y[4] = o1[0] * r * w1[0] * siluf_(z[4]); y[5] = o1[1] * r * w1[1] * siluf_(z[5]); y[6] = o1[2] * r * w1[2] * siluf_(z[6]); y[7] = o1[3] * r * w1[3] * siluf_(z[7]);
        *(u32x4*)(mix + (size_t)row * 1024 + 8 * lane) = pack8(y);
    }
}
__device__ __forceinline__ void phase_ffnconv(const Args& a, int hf) {
    const bf16_t* up = (const bf16_t*)(a.ws + WS_UPH); bf16_t* act = (bf16_t*)(a.ws + WS_ACT);
    const float* fw = a.in[13]; const float* fb = a.in[14];
    const int total = 16384 * 352;
    for (int it = blockIdx.x * NT + threadIdx.x; it < total; it += gridDim.x * NT) {
        const int rl = it / 352, p = it - rl * 352, j0 = p * 8, pn = j0 >> 7, jj = j0 & 127, row = hf * 16384 + rl, t = row & 2047, gcol = 256 * pn + jj;
        float g[8], v[8];
        { const f32x4 b0 = *(const f32x4*)(fb + j0), b1 = *(const f32x4*)(fb + j0 + 4), c0 = *(const f32x4*)(fb + DFF + j0), c1 = *(const f32x4*)(fb + DFF + j0 + 4);
          g[0] = b0[0]; g[1] = b0[1]; g[2] = b0[2]; g[3] = b0[3]; g[4] = b1[0]; g[5] = b1[1]; g[6] = b1[2]; g[7] = b1[3];
          v[0] = c0[0]; v[1] = c0[1]; v[2] = c0[2]; v[3] = c0[3]; v[4] = c1[0]; v[5] = c1[1]; v[6] = c1[2]; v[7] = c1[3]; }
#pragma unroll
        for (int i = 0; i < 3; ++i) { if (t - 2 + i >= 0) {
            float gf[8], vf[8]; unpack8(*(const u32x4*)(up + (size_t)(rl - 2 + i) * NUP + gcol), gf); unpack8(*(const u32x4*)(up + (size_t)(rl - 2 + i) * NUP + gcol + 128), vf);
            const float* wg = fw + (size_t)i * NUP + j0; const float* wv = wg + DFF;
            const f32x4 a0 = *(const f32x4*)wg, a1 = *(const f32x4*)(wg + 4), e0 = *(const f32x4*)wv, e1 = *(const f32x4*)(wv + 4);
            g[0] += gf[0] * a0[0]; g[1] += gf[1] * a0[1]; g[2] += gf[2] * a0[2]; g[3] += gf[3] * a0[3]; g[4] += gf[4] * a1[0]; g[5] += gf[5] * a1[1]; g[6] += gf[6] * a1[2]; g[7] += gf[7] * a1[3];
            v[0] += vf[0] * e0[0]; v[1] += vf[1] * e0[1]; v[2] += vf[2] * e0[2]; v[3] += vf[3] * e0[3]; v[4] += vf[4] * e1[0]; v[5] += vf[5] * e1[1]; v[6] += vf[6] * e1[2]; v[7] += vf[7] * e1[3]; } }
        float o[8];
#pragma unroll
        for (int e = 0; e < 8; ++e) o[e] = siluf_(g[e]) * v[e];
        *(u32x4*)(act + (size_t)row * DFF + j0) = pack8(o);
    }
}
__device__ __forceinline__ void phase_final(const Args& a) {
    const int tid = threadIdx.x, lane = tid & 63, wave = tid >> 6; const float* fw = a.in[16];
    const bf16_t* yb = (const bf16_t*)(a.ws + WS_YB); const float* ss3 = (const float*)(a.ws + WS_SS3);
    f32x4 nwv[4];
#pragma unroll
    for (int j = 0; j < 2; ++j) { nwv[2 * j] = *(const f32x4*)(fw + 512 * j + 8 * lane); nwv[2 * j + 1] = *(const f32x4*)(fw + 512 * j + 8 * lane + 4); }
    for (int row = blockIdx.x * 8 + wave; row < M; row += gridDim.x * 8) {
        const u32x4 y0 = *(const u32x4*)(yb + (size_t)row * 1024 + 8 * lane), y1 = *(const u32x4*)(yb + (size_t)row * 1024 + 512 + 8 * lane);
        const f32x4 s0 = *(const f32x4*)(ss3 + (size_t)row * 16), s1 = *(const f32x4*)(ss3 + (size_t)row * 16 + 4), s2 = *(const f32x4*)(ss3 + (size_t)row * 16 + 8), s3 = *(const f32x4*)(ss3 + (size_t)row * 16 + 12);
        const float ss = ((s0[0] + s0[1]) + (s0[2] + s0[3])) + ((s1[0] + s1[1]) + (s1[2] + s1[3])) + ((s2[0] + s2[1]) + (s2[2] + s2[3])) + ((s3[0] + s3[1]) + (s3[2] + s3[3]));
        const float rstd = rsqrtf(ss * (1.0f / 1024.0f) + EPS);
        float f0[8], f1[8]; unpack8(y0, f0); unpack8(y1, f1);
        float* op = a.out + (size_t)row * 1024 + 8 * lane;
        *(f32x4*)op = (f32x4){f0[0], f0[1], f0[2], f0[3]} * rstd * nwv[0]; *(f32x4*)(op + 4) = (f32x4){f0[4], f0[5], f0[6], f0[7]} * rstd * nwv[1];
        *(f32x4*)(op + 512) = (f32x4){f1[0], f1[1], f1[2], f1[3]} * rstd * nwv[2]; *(f32x4*)(op + 516) = (f32x4){f1[4], f1[5], f1[6], f1[7]} * rstd * nwv[3];
    }
}

#define XB_TMO      128
#define XB_XCNT(j)  (256  + 64 * (j))
#define XB_XSUB(j)  (1280 + 64 * (j))
#define XB_XGEN(j)  (2304 + 64 * (j))
#define XB_TOP      3328
#define XB_TOPGEN   3392
#define XCD_BAR_WORDS 3456
#define XB_SPIN_CAP (1u << 18)
#define LAS __attribute__((address_space(3)))

__device__ __forceinline__ unsigned xb_ld(unsigned* p)              { return __hip_atomic_load(p, __ATOMIC_RELAXED, __HIP_MEMORY_SCOPE_AGENT); }
__device__ __forceinline__ unsigned xb_add(unsigned* p, unsigned v) { return __hip_atomic_fetch_add(p, v, __ATOMIC_RELAXED, __HIP_MEMORY_SCOPE_AGENT); }
__device__ __forceinline__ unsigned xb_xcc_id() { return (unsigned)__builtin_amdgcn_s_getreg((3 << 11) | 20) & 0xFu; }
#define XB_SPIN(cond, bar) do { unsigned _sp = 0; while (cond) { __builtin_amdgcn_s_sleep(1); \
    if ((++_sp & 255u) == 0u) { if (xb_ld(&(bar)[XB_TMO])) break; if (_sp > XB_SPIN_CAP) { atomicAdd(&(bar)[XB_TMO], 1u); break; } } } } while (0)

struct XcdBarrier {
    unsigned* bar; unsigned x;
    volatile LAS unsigned* st;
};

__device__ __forceinline__ XcdBarrier xcd_barrier_post(unsigned* bar, volatile LAS unsigned* st) {
    XcdBarrier b; b.bar = bar; b.x = xb_xcc_id(); b.st = st;
    if (threadIdx.x == 0) (void)xb_add(&bar[XB_XCNT(b.x)], 1u);
    return b;
}
__device__ __forceinline__ void xcd_barrier_complete(unsigned* bar, unsigned x, unsigned& nloc, unsigned& nx) {
    const unsigned G = gridDim.x * gridDim.y * gridDim.z;
    unsigned sum, cnt, mine, sp = 0u;
    for (;;) {
        sum = 0u; cnt = 0u; mine = 0u;
#pragma unroll
        for (unsigned j = 0; j < 16; ++j) { const unsigned c = xb_ld(&bar[XB_XCNT(j)]); sum += c; cnt += (c > 0u) ? 1u : 0u; mine = (j == x) ? c : mine; }
        if (sum == G) break;
        __builtin_amdgcn_s_sleep(1);
        if ((++sp & 255u) == 0u) { if (xb_ld(&bar[XB_TMO])) break; if (sp > XB_SPIN_CAP) { atomicAdd(&bar[XB_TMO], 1u); break; } }
    }
    nloc = mine > 0u ? mine : 1u; nx = cnt > 0u ? cnt : 1u;
}

__device__ __forceinline__ void xcd_barrier(const XcdBarrier& b) {
    asm volatile("s_waitcnt vmcnt(0)" ::: "memory");
    __syncthreads();
    if (threadIdx.x == 0) {
        unsigned* bar = b.bar;
        __builtin_amdgcn_s_waitcnt(0);
        unsigned nloc = b.st[0], nx = b.st[1];
        if (nloc == 0u) { xcd_barrier_complete(bar, b.x, nloc, nx); b.st[0] = nloc; b.st[1] = nx; }
        const unsigned old = xb_add(&bar[XB_XSUB(b.x)], 1u);
        const unsigned gen = old / nloc;
        if (old + 1u == (gen + 1u) * nloc) {
            __builtin_amdgcn_fence(__ATOMIC_RELEASE, "agent");
            asm volatile("s_waitcnt vmcnt(0)" ::: "memory");
            const unsigned og = xb_add(&bar[XB_TOP], 1u);
            const unsigned tg = og / nx;
            if (og + 1u == (tg + 1u) * nx) xb_add(&bar[XB_TOPGEN], 1u);
            else XB_SPIN(xb_ld(&bar[XB_TOPGEN]) == tg, bar);
            __builtin_amdgcn_fence(__ATOMIC_ACQUIRE, "agent");
            xb_add(&bar[XB_XGEN(b.x)], 1u);
            asm volatile("s_waitcnt vmcnt(0)" ::: "memory");
        } else {
            XB_SPIN(xb_ld(&bar[XB_XGEN(b.x)]) == gen, bar);
            __builtin_amdgcn_fence(__ATOMIC_ACQUIRE, "agent");
            asm volatile("s_waitcnt vmcnt(0)" ::: "memory");
        }
    }
    __syncthreads();
}


__global__ void __launch_bounds__(NT) mega(Args a) {
    extern __shared__ __attribute__((aligned(16))) unsigned char lds_raw[];
    cg::grid_group grid = cg::this_grid();
    PG8_LAS unsigned char* lds = (PG8_LAS unsigned char*)lds_raw;
    volatile LAS unsigned* xst = (volatile LAS unsigned*)(lds + 131072);
    if (threadIdx.x < 4) xst[threadIdx.x] = 0u;
    __syncthreads();
    XcdBarrier xbar = xcd_barrier_post((unsigned*)(a.ws + WS_BAR), xst);
    bf16_t* WinT = (bf16_t*)(a.ws + WS_WIN); bf16_t* WoutT = (bf16_t*)(a.ws + WS_WOUT); bf16_t* WupT = (bf16_t*)(a.ws + WS_WUP); bf16_t* WdownT = (bf16_t*)(a.ws + WS_WDOWN);
    bf16_t* h1b = (bf16_t*)a.out; bf16_t* proj = (bf16_t*)(a.ws + WS_PROJ); bf16_t* mix = (bf16_t*)(a.ws + WS_MIX); bf16_t* xb = (bf16_t*)(a.ws + WS_XB);
    bf16_t* uph = (bf16_t*)(a.ws + WS_UPH); bf16_t* act = (bf16_t*)(a.ws + WS_ACT); float* ss2 = (float*)(a.ws + WS_SS2);

    const unsigned mk = a.mask;
    if (mk & 1u) { phase_weights(a, (PG8_LAS float*)lds, 0, TW_B, (int)blockIdx.x, (int)gridDim.x); }
    __syncthreads();
    if (mk & 2048u) phase_norm1(a, (float*)lds_raw);
    grid.sync();
    if (mk & 2u)
    { pg8::Gemm g{h1b, WinT, M, NPROJ, D}; pg8::StaticOrder S; S.init(M, NPROJ, (int)gridDim.x, (int)blockIdx.x); EpiBf16Plain E{proj, NPROJ, (const float*)(a.ws + WS_RS1)};
      pg8::gemm_phase<EpiBf16Plain, pg8::StaticOrder, true, true>(lds, g, S, E); }
    xcd_barrier(xbar);
    if (mk & 4u) phase_qkv(a);
    xcd_barrier(xbar);
    if (mk & 8u) phase_prep(a, lds);
    xcd_barrier(xbar);
    if (gridDim.x >= 256) { if (blockIdx.x < 128) { if (mk & 16u) phase_scan(a, lds, (int)blockIdx.x); } else if (mk & 4096u) { phase_pool(a, lds, (int)blockIdx.x - 128, (int)gridDim.x - 128); phase_weights(a, (PG8_LAS float*)lds, TW_B, TW_END, (int)blockIdx.x - 128, (int)gridDim.x - 128); } }
    else { if (mk & 16u) for (int sb = blockIdx.x; sb < 128; sb += gridDim.x) phase_scan(a, lds, sb); if (mk & 4096u) { phase_pool(a, lds, (int)blockIdx.x, (int)gridDim.x & ~3); phase_weights(a, (PG8_LAS float*)lds, TW_B, TW_END, (int)blockIdx.x, (int)gridDim.x); } }
    xcd_barrier(xbar);
    if (mk & 32u) phase_gate(a);
    xcd_barrier(xbar);
    if (mk & 64u)
    { pg8::Gemm g{mix, WoutT, M, D, D}; pg8::StaticOrder S; S.init(M, D, (int)gridDim.x, (int)blockIdx.x); EpiOutProj E{(const bf16_t*)a.out, xb, ss2};
      pg8::gemm_phase<EpiOutProj, pg8::StaticOrder, true, true>(lds, g, S, E); }
    xcd_barrier(xbar);
    if (mk & 128u)
    { pg8::Gemm g{xb, WupT, M, NUP, D}; pg8::StaticOrder S; S.init(M, NUP, (int)gridDim.x, (int)blockIdx.x); EpiUpFused E{act, (bf16_t*)(a.ws + WS_HALO), ss2, a.in[13], a.in[14], lds + 131072 + 256};
      pg8::gemm_phase<EpiUpFused, pg8::StaticOrder, true, true>(lds, g, S, E); }
    xcd_barrier(xbar);
    if (mk & 256u) phase_fixup(a);
    xcd_barrier(xbar);
    if (mk & 512u)
    { pg8::Gemm g{act, WdownT, M, D, DFF}; pg8::StaticOrder S; S.init(M, D, (int)gridDim.x, (int)blockIdx.x); EpiDown E{xb, (bf16_t*)(a.ws + WS_YB), (float*)(a.ws + WS_SS3)};
      pg8::gemm_phase<EpiDown, pg8::StaticOrder, true, true>(lds, g, S, E); }
    xcd_barrier(xbar);
    if (mk & 1024u) phase_final(a);
}

extern "C" void kernel_launch(void* const* d_in, const int* in_sizes, int n_in, void* d_out, int out_size, void* d_ws, size_t ws_size, hipStream_t stream) {
    static int grid_blocks = 0;
    if (!grid_blocks) {
        int dev = 0, cus = 0, per_cu = 0;
        (void)hipGetDevice(&dev);
        (void)hipDeviceGetAttribute(&cus, hipDeviceAttributeMultiprocessorCount, dev);
        (void)hipFuncSetAttribute((const void*)mega, hipFuncAttributeMaxDynamicSharedMemorySize, LDS_BYTES);
        (void)hipOccupancyMaxActiveBlocksPerMultiprocessor(&per_cu, (const void*)mega, NT, LDS_BYTES);
        if (per_cu < 1) { fprintf(stderr, "occupancy query says %d\n", per_cu); per_cu = 1; }
        if (per_cu > 1) per_cu = 1;
        grid_blocks = cus * per_cu;
        if (ws_size < WS_END) fprintf(stderr, "workspace too small: %zu < %zu\n", ws_size, (size_t)WS_END);
    }
    Args a{};
    for (int i = 0; i < 17; ++i) a.in[i] = (const float*)d_in[i];
    a.out = (float*)d_out; a.ws = (unsigned char*)d_ws;
    (void)hipMemsetAsync((unsigned char*)d_ws + WS_BAR, 0, XCD_BAR_WORDS * 4, stream);
    void* args[] = {&a};
#ifdef PROBE_MASK
    a.mask = PROBE_MASK;
    (void)hipLaunchCooperativeKernel((const void*)mega, dim3(grid_blocks), dim3(NT), args, LDS_BYTES, stream);
    (void)hipMemsetAsync((unsigned char*)d_ws + WS_BAR, 0, XCD_BAR_WORDS * 4, stream);
#endif
    a.mask = 0x1fffu;
    hipError_t e = hipLaunchCooperativeKernel((const void*)mega, dim3(grid_blocks), dim3(NT), args, LDS_BYTES, stream);
    if (e != hipSuccess) fprintf(stderr, "cooperative launch failed: %s (grid %d)\n", hipGetErrorString(e), grid_blocks);
}
```

```cpp
#include <hip/hip_runtime.h>
#include <hip/hip_cooperative_groups.h>
#include <cstdio>
namespace cg = cooperative_groups;
namespace pg8 {
#define PG8_LAS __attribute__((address_space(3)))
typedef unsigned short bf16_t;
typedef short bf16x8 __attribute__((ext_vector_type(8)));
typedef float f32x4 __attribute__((ext_vector_type(4)));
typedef unsigned u32x4 __attribute__((ext_vector_type(4)));
constexpr int BM = 256, BK = 64, HALF = 128, HTB = HALF * BK * 2  , STAGE_BYTES = 8 * HTB, NXCD = 8, WGM = 8;

__host__ __device__ __forceinline__ int lds_byte(int r, int c) { const int st = (r >> 4) * 2 + (c >> 5), rr = r & 15, cc = c & 31, ob = rr * 64 + cc * 2; return st * 1024 + (ob ^ (((ob >> 9) & 1) << 5)); }
__host__ __device__ __forceinline__ void stage_rc(int b, int& R, int& C) { const int st = b / 1024, sb = b % 1024, swz = sb ^ (((sb >> 9) & 1) << 5); R = (st >> 1) * 16 + swz / 64; C = (st & 1) * 32 + (swz % 64) / 2; }
__host__ __device__ __forceinline__ int perm32(int rho) { const int n = rho >> 4, i = rho & 15; return 8 * (i >> 2) + 4 * n + (i & 3); }

struct Unit { int pm, pn; };
struct Gemm { const bf16_t* A; const bf16_t* Bt; int M, N, K; };
struct StaticOrder {
    int nM, nN, nwg, G, c;
    __host__ __device__ void init(int M, int N, int G_, int c_) { nM = M / BM; nN = N / BM; nwg = nM * nN; G = G_; c = c_; }
    __host__ __device__ bool next(int i, Unit& u) const {
        const long L = (long)i * G + c; if (L >= nwg) return false;
        int wgid = (int)L; { const int q = nwg / NXCD, r = nwg % NXCD, xcd = wgid % NXCD, off = wgid / NXCD; wgid = (xcd < r ? xcd * (q + 1) : r * (q + 1) + (xcd - r) * q) + off; }
        const int nig = WGM * nN, gid = wgid / nig, fm = gid * WGM, gsz = (nM - fm) < WGM ? (nM - fm) : WGM;
        u.pm = fm + ((wgid % nig) % gsz); u.pn = (wgid % nig) / gsz; return true;
    }
    __device__ __forceinline__ void a_ready(const Unit&) const {}
    __device__ __forceinline__ void done(const Unit&) const {}
};
__device__ __forceinline__ unsigned cvt_pk_bf16(float lo, float hi) { unsigned r; asm volatile("v_cvt_pk_bf16_f32 %0, %1, %2" : "=v"(r) : "v"(lo), "v"(hi)); return r; }
template <class Epi, class Sched, bool ALIGN_EPI = false, bool SP2 = false>
__device__ __forceinline__ void gemm_phase(PG8_LAS unsigned char* lds, const Gemm g, const Sched& S, const Epi& E) {
    const int tid = threadIdx.x, wid = __builtin_amdgcn_readfirstlane(tid >> 6), lane = tid & 63, wr = wid >> 2, wc = wid & 3, fr = lane & 15, fq = lane >> 4;
    const int K = g.K, nt = K / BK;
    unsigned voffA[2], voffB[2];
#pragma unroll
    for (int i = 0; i < 2; ++i) { int R, C; stage_rc(tid * 16 + i * 8192, R, C); const int Rb = Epi::PERM ? ((R & ~31) + perm32(R & 31)) : R;
        const int Ra = Epi::PERMA ? ((R & 64) + 4 * (R & 15) + ((R >> 4) & 3)) : R; voffA[i] = (unsigned)(Ra * K + C) * 2u; voffB[i] = (unsigned)(Rb * K + C) * 2u; }
    const size_t kstep = (size_t)(BK * 2);
    const size_t hstep = (size_t)HALF * K * 2;
    const size_t tstep = 2 * hstep;
    const unsigned ldsw = (unsigned)wid * 1024u;
    const int aoff = lds_byte(wr * 64 + fr, fq * 8), boff = lds_byte(wc * 32 + fr, fq * 8);
#define PG8_SA(b, h) (((b) * 2 + (h)) * HTB)
#define PG8_SB(b, h) ((4 + (b) * 2 + (h)) * HTB)
#define PG8_STAGE(bufoff, gbase, voff) do { _Pragma("unroll") for (int _i = 0; _i < 2; ++_i) \
        __builtin_amdgcn_global_load_lds((const unsigned*)((const char*)(gbase) + (voff)[_i]), (PG8_LAS unsigned*)(lds + (bufoff) + ldsw + _i * 8192), 16, 0, 0); } while (0)
#define PG8_LDA(dst, b, h) do { _Pragma("unroll") for (int m = 0; m < 4; ++m) _Pragma("unroll") for (int k = 0; k < 2; ++k) dst[m][k] = *(const PG8_LAS bf16x8*)(lds + PG8_SA(b, h) + aoff + m * 2048 + k * 1024); } while (0)
#define PG8_LDB(dst, b, h) do { _Pragma("unroll") for (int n = 0; n < 2; ++n) _Pragma("unroll") for (int k = 0; k < 2; ++k) dst[n][k] = *(const PG8_LAS bf16x8*)(lds + PG8_SB(b, h) + boff + n * 2048 + k * 1024); } while (0)
#define PG8_MMA(ai, bj, At, Bt) do { __builtin_amdgcn_s_setprio(1); _Pragma("unroll") for (int m = 0; m < 4; ++m) _Pragma("unroll") for (int n = 0; n < 2; ++n) _Pragma("unroll") for (int k = 0; k < 2; ++k) \
        acc[ai][bj][m][n] = __builtin_amdgcn_mfma_f32_16x16x32_bf16(Bt[n][k], At[m][k], acc[ai][bj][m][n], 0, 0, 0); __builtin_amdgcn_s_setprio(0); } while (0)
#define PG8_WAIT_V(n) asm volatile("s_waitcnt vmcnt(" #n ")" ::: "memory")
#define PG8_WAIT_L(n) asm volatile("s_waitcnt lgkmcnt(" #n ")" ::: "memory")
#define PG8_BAR __builtin_amdgcn_s_barrier()
#define PG8_SCHED __builtin_amdgcn_sched_barrier(0)
    Unit cur, nxt; int ui = 0;
    if (!S.next(0, cur)) return;
    f32x4 acc[2][2][4][2];
#pragma unroll
    for (int a = 0; a < 2; ++a)
#pragma unroll
        for (int b = 0; b < 2; ++b)
#pragma unroll
            for (int m = 0; m < 4; ++m)
#pragma unroll
                for (int n = 0; n < 2; ++n) acc[a][b][m][n] = (f32x4){0.f, 0.f, 0.f, 0.f};
    bf16x8 At[4][2], B0[2][2], B1[2][2];
    const char* cA = (const char*)g.A + (size_t)cur.pm * tstep; const char* cB = (const char*)g.Bt + (size_t)cur.pn * tstep;
    S.a_ready(cur);
    if constexpr (SP2) {
        PG8_STAGE(PG8_SB(0, 0), cB, voffB); PG8_STAGE(PG8_SB(0, 1), cB + hstep, voffB); PG8_STAGE(PG8_SA(0, 0), cA, voffA); PG8_STAGE(PG8_SA(0, 1), cA + hstep, voffA);
        if (wr == 1) PG8_BAR;
        PG8_WAIT_V(2); PG8_BAR;
        PG8_STAGE(PG8_SB(1, 0), cB + kstep, voffB); PG8_STAGE(PG8_SA(1, 0), cA + kstep, voffA); PG8_STAGE(PG8_SB(1, 1), cB + hstep + kstep, voffB);
        PG8_WAIT_V(6); PG8_BAR;
    } else {
        PG8_STAGE(PG8_SB(0, 0), cB, voffB); PG8_STAGE(PG8_SA(0, 0), cA, voffA); PG8_STAGE(PG8_SB(0, 1), cB + hstep, voffB); PG8_STAGE(PG8_SA(0, 1), cA + hstep, voffA);
        if (wr == 1) PG8_BAR;
        PG8_WAIT_V(4); PG8_BAR;
        PG8_STAGE(PG8_SB(1, 0), cB + kstep, voffB); PG8_STAGE(PG8_SA(1, 0), cA + kstep, voffA); PG8_STAGE(PG8_SB(1, 1), cB + hstep + kstep, voffB);
        PG8_WAIT_V(6); PG8_BAR;
    }
    for (;;) {
        const bool has_next = S.next(ui + 1, nxt);
        const char* nA = has_next ? (const char*)g.A + (size_t)nxt.pm * tstep : cA; const char* nB = has_next ? (const char*)g.Bt + (size_t)nxt.pn * tstep : cB;
        for (int t = 0; t < nt; t += 2) {
            const bool last = (t == nt - 2);
            const char* a1 = cA + (size_t)(t + 1) * kstep;
            const char* a2 = last ? nA : cA + (size_t)(t + 2) * kstep; const char* b2 = last ? nB : cB + (size_t)(t + 2) * kstep;
            const char* a3 = a2 + kstep; const char* b3 = b2 + kstep;
            if (last && has_next) S.a_ready(nxt);
            if constexpr (SP2) {
            PG8_LDB(B0, 0, 0); PG8_LDB(B1, 0, 1); PG8_SCHED; PG8_LDA(At, 0, 0); PG8_STAGE(PG8_SA(1, 1), a1 + hstep, voffA);
            PG8_WAIT_V(8); PG8_WAIT_L(0); PG8_BAR; PG8_MMA(0, 0, At, B0); PG8_MMA(0, 1, At, B1); PG8_BAR; PG8_SCHED;
            PG8_LDA(At, 0, 1); PG8_STAGE(PG8_SB(0, 0), b2, voffB); PG8_STAGE(PG8_SB(0, 1), b2 + hstep, voffB); PG8_STAGE(PG8_SA(0, 0), a2, voffA);
            PG8_WAIT_V(8); PG8_WAIT_L(0); PG8_BAR; PG8_MMA(1, 0, At, B0); PG8_MMA(1, 1, At, B1); PG8_BAR; PG8_SCHED;
            PG8_LDB(B0, 1, 0); PG8_LDB(B1, 1, 1); PG8_SCHED; PG8_LDA(At, 1, 0); PG8_STAGE(PG8_SA(0, 1), a2 + hstep, voffA);
            PG8_WAIT_V(8); PG8_WAIT_L(0); PG8_BAR; PG8_MMA(0, 0, At, B0); PG8_MMA(0, 1, At, B1); PG8_BAR; PG8_SCHED;
            PG8_LDA(At, 1, 1); PG8_STAGE(PG8_SB(1, 0), b3, voffB); PG8_STAGE(PG8_SB(1, 1), b3 + hstep, voffB); PG8_STAGE(PG8_SA(1, 0), a3, voffA);
            PG8_WAIT_V(8); PG8_WAIT_L(0); PG8_BAR; PG8_MMA(1, 0, At, B0); PG8_MMA(1, 1, At, B1); PG8_BAR; PG8_SCHED;
            } else {
            PG8_LDB(B0, 0, 0); PG8_SCHED; PG8_LDA(At, 0, 0); PG8_STAGE(PG8_SA(1, 1), a1 + hstep, voffA);
            PG8_WAIT_L(8); PG8_BAR; PG8_WAIT_L(0); PG8_MMA(0, 0, At, B0); PG8_BAR; PG8_SCHED;
            PG8_LDB(B1, 0, 1); PG8_STAGE(PG8_SB(0, 0), b2, voffB);
            PG8_BAR; PG8_WAIT_L(0); PG8_MMA(0, 1, At, B1); PG8_BAR;
            PG8_LDA(At, 0, 1); PG8_STAGE(PG8_SA(0, 0), a2, voffA);
            PG8_BAR; PG8_WAIT_L(0); PG8_MMA(1, 0, At, B0); PG8_BAR; PG8_SCHED;
            PG8_STAGE(PG8_SB(0, 1), b2 + hstep, voffB);
            PG8_WAIT_V(6); PG8_BAR; PG8_MMA(1, 1, At, B1); PG8_BAR;
            PG8_LDB(B0, 1, 0); PG8_SCHED; PG8_LDA(At, 1, 0); PG8_STAGE(PG8_SA(0, 1), a2 + hstep, voffA);
            PG8_WAIT_L(8); PG8_BAR; PG8_WAIT_L(0); PG8_MMA(0, 0, At, B0); PG8_BAR; PG8_SCHED;
            PG8_LDB(B1, 1, 1); PG8_STAGE(PG8_SB(1, 0), b3, voffB);
            PG8_BAR; PG8_WAIT_L(0); PG8_MMA(0, 1, At, B1); PG8_BAR;
            PG8_LDA(At, 1, 1); PG8_STAGE(PG8_SA(1, 0), a3, voffA);
            PG8_BAR; PG8_WAIT_L(0); PG8_MMA(1, 0, At, B0); PG8_BAR; PG8_SCHED;
            PG8_STAGE(PG8_SB(1, 1), b3 + hstep, voffB);
            PG8_WAIT_V(6); PG8_BAR; PG8_MMA(1, 1, At, B1); PG8_BAR;
            }
        }
        if constexpr (ALIGN_EPI) { if (wr == 0) PG8_BAR; }
        if constexpr (!Epi::AFTER_DRAIN) { E(acc, cur, wr, wc, fr, fq); S.done(cur); }
        if (!has_next) break;
#pragma unroll
        for (int a = 0; a < 2; ++a)
#pragma unroll
            for (int b = 0; b < 2; ++b)
#pragma unroll
                for (int m = 0; m < 4; ++m)
#pragma unroll
                    for (int n = 0; n < 2; ++n) acc[a][b][m][n] = (f32x4){0.f, 0.f, 0.f, 0.f};
        cur = nxt; cA = nA; cB = nB; ++ui;
        if constexpr (ALIGN_EPI) { if (wr == 1) PG8_BAR; }
    }
    PG8_WAIT_V(0);
    if constexpr (!ALIGN_EPI) { if (wr == 0) PG8_BAR; }
    PG8_BAR;
    if constexpr (Epi::AFTER_DRAIN) { E.fused(acc, cur, wr, wc, fr, fq, lds, wid, lane); S.done(cur); }
#undef PG8_SA
#undef PG8_SB
#undef PG8_STAGE
#undef PG8_LDA
#undef PG8_LDB
#undef PG8_MMA
#undef PG8_WAIT_V
#undef PG8_WAIT_L
#undef PG8_BAR
#undef PG8_SCHED
}
}

typedef pg8::bf16_t bf16_t;
typedef pg8::f32x4 f32x4;
typedef pg8::u32x4 u32x4;
typedef unsigned u32x2 __attribute__((ext_vector_type(2)));

constexpr int M = 32768, D = 1024, NPROJ = 2560, DFF = 2816, NUP = 5632;
constexpr float EPS = 1e-6f;
constexpr size_t MBY = 1048576;
constexpr size_t WS_WIN = 0, WS_WOUT = 5 * MBY, WS_WUP = 7 * MBY, WS_WDOWN = 18 * MBY, WS_BETA = 24 * MBY, WS_G = 24 * MBY + MBY / 2, WS_SS2 = 25 * MBY;
constexpr size_t WS_H1B = 32 * MBY, WS_MIX = 32 * MBY, WS_PROJ = 96 * MBY, WS_QB = 256 * MBY, WS_KB = 288 * MBY, WS_VB = 320 * MBY, WS_OF = 352 * MBY;
constexpr size_t WS_XB = 96 * MBY, WS_UPH = 160 * MBY, WS_ACT = 336 * MBY, WS_END = 512 * MBY;
constexpr size_t WS_KT = 32 * MBY, WS_VT = 64 * MBY, WS_RS1 = 27 * MBY + 262144;
constexpr int LDS_BYTES = 131072 + 256 + 8192, NT = 512;
constexpr size_t WS_BAR = 30 * MBY;

struct Args { const float* in[17]; float* out; unsigned char* ws; unsigned mask; unsigned pad; };

__device__ __forceinline__ float bf_lo(unsigned w) { return __uint_as_float(w << 16); }
__device__ __forceinline__ float bf_hi(unsigned w) { return __uint_as_float(w & 0xffff0000u); }
typedef float f32x2_ __attribute__((ext_vector_type(2)));
typedef __bf16 bf16x2_ __attribute__((ext_vector_type(2)));
__device__ __forceinline__ unsigned pk2(float a, float b) { return pg8::cvt_pk_bf16(a, b); }
__device__ __forceinline__ unsigned pk2c(float a, float b) { const f32x2_ v = {a, b}; const bf16x2_ r = __builtin_convertvector(v, bf16x2_); return __builtin_bit_cast(unsigned, r); }
__device__ __forceinline__ void unpack8(const u32x4 w, float (&f)[8]) { f[0] = bf_lo(w.x); f[1] = bf_hi(w.x); f[2] = bf_lo(w.y); f[3] = bf_hi(w.y); f[4] = bf_lo(w.z); f[5] = bf_hi(w.z); f[6] = bf_lo(w.w); f[7] = bf_hi(w.w); }
__device__ __forceinline__ u32x4 pack8(const float (&f)[8]) { u32x4 o; o.x = pk2(f[0], f[1]); o.y = pk2(f[2], f[3]); o.z = pk2(f[4], f[5]); o.w = pk2(f[6], f[7]); return o; }
__device__ __forceinline__ float wave_sum(float v) {
#pragma unroll
    for (int o = 1; o < 64; o <<= 1) v += __shfl_xor(v, o);
    return v;
}
template <int CTRL> __device__ __forceinline__ float dpp_mov(float x) { return __builtin_bit_cast(float, __builtin_amdgcn_update_dpp(0, __builtin_bit_cast(int, x), CTRL, 0xf, 0xf, true)); }
__device__ __forceinline__ float sum16(float v) {
    v += dpp_mov<0x128>(v); v += dpp_mov<0x124>(v); v += dpp_mov<0x122>(v); v += dpp_mov<0x121>(v);
    return v;
}
__device__ __forceinline__ float row_up1(float v) { return dpp_mov<0x111>(v); }
__device__ __forceinline__ float sigmoidf_(float x) { return __builtin_amdgcn_rcpf(1.0f + __builtin_amdgcn_exp2f(x * -1.4426950408889634f)); }
__device__ __forceinline__ float siluf_(float x) { return x * __builtin_amdgcn_rcpf(1.0f + __builtin_amdgcn_exp2f(x * -1.4426950408889634f)); }

struct EpiBf16Plain {
    static constexpr bool PERM = true, PERMA = false, AFTER_DRAIN = false;
    bf16_t* O; int ldc; const float* RS;
    __device__ __forceinline__ void operator()(const f32x4 (&acc)[2][2][4][2], const pg8::Unit& u, int wr, int wc, int fr, int fq) const {
        const int row0 = u.pm * 256 + wr * 64 + fr, col0 = u.pn * 256 + wc * 32 + 8 * fq;
        float rs[2][4];
#pragma unroll
        for (int ai = 0; ai < 2; ++ai)
#pragma unroll
            for (int m = 0; m < 4; ++m) rs[ai][m] = RS[row0 + ai * 128 + m * 16];
#pragma unroll
        for (int ai = 0; ai < 2; ++ai)
#pragma unroll
            for (int m = 0; m < 4; ++m) { bf16_t* rowp = O + (size_t)(row0 + ai * 128 + m * 16) * ldc + col0;
#pragma unroll
                for (int bj = 0; bj < 2; ++bj) { const f32x4 v0 = acc[ai][bj][m][0] * rs[ai][m], v1 = acc[ai][bj][m][1] * rs[ai][m];
                    u32x4 w; w.x = pk2(v0[0], v0[1]); w.y = pk2(v0[2], v0[3]); w.z = pk2(v1[0], v1[1]); w.w = pk2(v1[2], v1[3]);
                    *(u32x4*)(rowp + bj * 128) = w; } }
    }
};
struct EpiOutProj {
    static constexpr bool PERM = true, PERMA = false, AFTER_DRAIN = false;
    const bf16_t* X; bf16_t* XB; float* SS;
    __device__ __forceinline__ void operator()(f32x4 (&acc)[2][2][4][2], const pg8::Unit& u, int wr, int wc, int fr, int fq) const {
        const int row0 = u.pm * 256 + wr * 64 + fr, col0 = u.pn * 256 + wc * 32 + 8 * fq;
#pragma unroll
        for (int ai = 0; ai < 2; ++ai) {
            f32x4 rx[4][2][2];
#pragma unroll
            for (int m = 0; m < 4; ++m)
#pragma unroll
                for (int bj = 0; bj < 2; ++bj) { float f[8]; unpack8(*(const u32x4*)(X + (size_t)(row0 + ai * 128 + m * 16) * 1024 + col0 + bj * 128), f);
                    rx[m][bj][0] = (f32x4){f[0], f[1], f[2], f[3]}; rx[m][bj][1] = (f32x4){f[4], f[5], f[6], f[7]}; }
#pragma unroll
            for (int m = 0; m < 4; ++m) { const int row = row0 + ai * 128 + m * 16; float s = 0.f;
#pragma unroll
                for (int bj = 0; bj < 2; ++bj) { const f32x4 v0 = acc[ai][bj][m][0] + rx[m][bj][0], v1 = acc[ai][bj][m][1] + rx[m][bj][1];
                    s += (v0[0] * v0[0] + v0[1] * v0[1]) + (v0[2] * v0[2] + v0[3] * v0[3]) + (v1[0] * v1[0] + v1[1] * v1[1]) + (v1[2] * v1[2] + v1[3] * v1[3]);
                    u32x4 w; w.x = pk2(v0[0], v0[1]); w.y = pk2(v0[2], v0[3]); w.z = pk2(v1[0], v1[1]); w.w = pk2(v1[2], v1[3]);
                    *(u32x4*)(XB + (size_t)row * 1024 + col0 + bj * 128) = w; }
                s += __shfl_xor(s, 16); s += __shfl_xor(s, 32); if (fq == 0) SS[(size_t)row * 16 + u.pn * 4 + wc] = s; }
        }
    }
};
constexpr size_t WS_YB = 192 * MBY, WS_SS3 = 25 * MBY;
struct EpiDown {
    static constexpr bool PERM = true, PERMA = false, AFTER_DRAIN = false;
    const bf16_t* XB; bf16_t* YB; float* SS;
    __device__ __forceinline__ void operator()(f32x4 (&acc)[2][2][4][2], const pg8::Unit& u, int wr, int wc, int fr, int fq) const {
        const int row0 = u.pm * 256 + wr * 64 + fr, col0 = u.pn * 256 + wc * 32 + 8 * fq;
#pragma unroll
        for (int ai = 0; ai < 2; ++ai) {
            u32x4 rx[4][2];
#pragma unroll
            for (int m = 0; m < 4; ++m)
#pragma unroll
                for (int bj = 0; bj < 2; ++bj) rx[m][bj] = *(const u32x4*)(XB + (size_t)(row0 + ai * 128 + m * 16) * 1024 + col0 + bj * 128);
#pragma unroll
            for (int m = 0; m < 4; ++m) { const int row = row0 + ai * 128 + m * 16; float s = 0.f;
#pragma unroll
                for (int bj = 0; bj < 2; ++bj) { float f[8]; unpack8(rx[m][bj], f);
                    const f32x4 v0 = acc[ai][bj][m][0] + (f32x4){f[0], f[1], f[2], f[3]}, v1 = acc[ai][bj][m][1] + (f32x4){f[4], f[5], f[6], f[7]};
                    s += (v0[0] * v0[0] + v0[1] * v0[1]) + (v0[2] * v0[2] + v0[3] * v0[3]) + (v1[0] * v1[0] + v1[1] * v1[1]) + (v1[2] * v1[2] + v1[3] * v1[3]);
                    u32x4 w; w.x = pk2(v0[0], v0[1]); w.y = pk2(v0[2], v0[3]); w.z = pk2(v1[0], v1[1]); w.w = pk2(v1[2], v1[3]);
                    *(u32x4*)(YB + (size_t)row * 1024 + col0 + bj * 128) = w; }
                s += __shfl_xor(s, 16); s += __shfl_xor(s, 32); if (fq == 0) SS[(size_t)row * 16 + u.pn * 4 + wc] = s; }
        }
    }
};
struct EpiUpRaw {
    static constexpr bool PERM = true, PERMA = false, AFTER_DRAIN = false;
    bf16_t* O; const float* SS;
    __device__ __forceinline__ void operator()(const f32x4 (&acc)[2][2][4][2], const pg8::Unit& u, int wr, int wc, int fr, int fq) const {
        const int row0 = u.pm * 256 + wr * 64 + fr, col0 = u.pn * 256 + wc * 32 + 8 * fq;
#pragma unroll
        for (int ai = 0; ai < 2; ++ai)
#pragma unroll
            for (int m = 0; m < 4; ++m) { const int row = row0 + ai * 128 + m * 16;
                const f32x4 sv = *(const f32x4*)(SS + (size_t)row * 16 + 4 * fq); float s = (sv[0] + sv[1]) + (sv[2] + sv[3]); s += __shfl_xor(s, 16); s += __shfl_xor(s, 32);
                const float rstd = rsqrtf(s * (1.0f / 1024.0f) + EPS);
                bf16_t* rowp = O + (size_t)row * NUP + col0;
#pragma unroll
                for (int bj = 0; bj < 2; ++bj) { const f32x4 v0 = acc[ai][bj][m][0] * rstd, v1 = acc[ai][bj][m][1] * rstd;
                    u32x4 w; w.x = pk2(v0[0], v0[1]); w.y = pk2(v0[2], v0[3]); w.z = pk2(v1[0], v1[1]); w.w = pk2(v1[2], v1[3]);
                    *(u32x4*)(rowp + bj * 128) = w; } }
    }
};

constexpr size_t WS_HALO = 160 * MBY, WS_PWT = 28 * MBY;
struct EpiUpFused {
    static constexpr bool PERM = true, PERMA = true, AFTER_DRAIN = false;
    bf16_t* ACT; bf16_t* HALO; const float* SS; const float* FW; const float* FB; PG8_LAS unsigned char* WL;
    __device__ __forceinline__ void operator()(f32x4 (&acc)[2][2][4][2], const pg8::Unit& u, int wr, int wc, int fr, int fq) const {
        const int colj = u.pn * 128 + wc * 32 + 8 * fq;
        PG8_LAS unsigned char* wl = WL + (wr * 4 + wc) * 1024;
        {
            const int l = fq * 16 + fr, p = l >> 4, bj = (l >> 3) & 1, c4 = (l & 7) * 4;
            const float* srcp = (p < 3 ? FW + p * NUP : FB) + bj * DFF + u.pn * 128 + wc * 32 + c4;
            *(PG8_LAS f32x4*)(wl + l * 16) = *(const f32x4*)srcp;
        }
#pragma unroll
        for (int ai = 0; ai < 2; ++ai) {
            const int tb = u.pm * 256 + ai * 128 + wr * 64 + 4 * fr;
            float rstd[4];
#pragma unroll
            for (int m = 0; m < 4; ++m) { const f32x4 sv = *(const f32x4*)(SS + (size_t)(tb + m) * 16 + 4 * fq); float s = (sv[0] + sv[1]) + (sv[2] + sv[3]); s += __shfl_xor(s, 16); s += __shfl_xor(s, 32);
                rstd[m] = rsqrtf(s * (1.0f / 1024.0f) + EPS); }
            u32x2 pk[2][4];
#pragma unroll
            for (int n = 0; n < 2; ++n) {
                f32x4 g[4];
                {   const PG8_LAS unsigned char* wq = wl + (8 * fq + 4 * n) * 4;
                    const f32x4 w0 = *(const PG8_LAS f32x4*)(wq), w1 = *(const PG8_LAS f32x4*)(wq + 256), w2 = *(const PG8_LAS f32x4*)(wq + 512), bb = *(const PG8_LAS f32x4*)(wq + 768);
                    const f32x4 x0 = acc[ai][0][0][n] * rstd[0], x1 = acc[ai][0][1][n] * rstd[1], x2 = acc[ai][0][2][n] * rstd[2], x3 = acc[ai][0][3][n] * rstd[3];
                    acc[ai][0][0][n] = x0; acc[ai][0][1][n] = x1; acc[ai][0][2][n] = x2; acc[ai][0][3][n] = x3;
                    f32x4 p1, p2;
#pragma unroll
                    for (int c = 0; c < 4; ++c) { p1[c] = row_up1(x3[c]); p2[c] = row_up1(x2[c]); }
                    g[0] = bb + w2 * x0 + w1 * p1 + w0 * p2; g[1] = bb + w2 * x1 + w1 * x0 + w0 * p1;
                    g[2] = bb + w2 * x2 + w1 * x1 + w0 * x0; g[3] = bb + w2 * x3 + w1 * x2 + w0 * x1;
#pragma unroll
                    for (int m = 0; m < 4; ++m)
#pragma unroll
                        for (int c = 0; c < 4; ++c) g[m][c] = siluf_(g[m][c]);
                }
                __builtin_amdgcn_sched_barrier(0);
                {   const PG8_LAS unsigned char* wq = wl + 128 + (8 * fq + 4 * n) * 4;
                    const f32x4 w0 = *(const PG8_LAS f32x4*)(wq), w1 = *(const PG8_LAS f32x4*)(wq + 256), w2 = *(const PG8_LAS f32x4*)(wq + 512), bb = *(const PG8_LAS f32x4*)(wq + 768);
                    const f32x4 x0 = acc[ai][1][0][n] * rstd[0], x1 = acc[ai][1][1][n] * rstd[1], x2 = acc[ai][1][2][n] * rstd[2], x3 = acc[ai][1][3][n] * rstd[3];
                    acc[ai][1][0][n] = x0; acc[ai][1][1][n] = x1; acc[ai][1][2][n] = x2; acc[ai][1][3][n] = x3;
                    f32x4 p1, p2;
#pragma unroll
                    for (int c = 0; c < 4; ++c) { p1[c] = row_up1(x3[c]); p2[c] = row_up1(x2[c]); }
                    g[0] *= bb + w2 * x0 + w1 * p1 + w0 * p2; g[1] *= bb + w2 * x1 + w1 * x0 + w0 * p1;
                    g[2] *= bb + w2 * x2 + w1 * x1 + w0 * x0; g[3] *= bb + w2 * x3 + w1 * x2 + w0 * x1;
                }
#pragma unroll
                for (int m = 0; m < 4; ++m) { pk[n][m].x = pk2(g[m][0], g[m][1]); pk[n][m].y = pk2(g[m][2], g[m][3]); }
                __builtin_amdgcn_sched_barrier(0);
            }
#pragma unroll
            for (int m = 0; m < 4; ++m) if (fr != 0 || m >= 2) {
                u32x4 w; w.x = pk[0][m].x; w.y = pk[0][m].y; w.z = pk[1][m].x; w.w = pk[1][m].y;
                *(u32x4*)(ACT + (size_t)(tb + m) * DFF + colj) = w; }
            const int seg = u.pm * 4 + ai * 2 + wr;
            if (fr == 0 || fr == 15) {
#pragma unroll
                for (int mm = 0; mm < 2; ++mm) { const int m = (fr == 0) ? mm : 2 + mm;
#pragma unroll
                    for (int bj = 0; bj < 2; ++bj) { const f32x4 v0 = (fr == 0) ? acc[ai][bj][mm][0] : acc[ai][bj][2 + mm][0], v1 = (fr == 0) ? acc[ai][bj][mm][1] : acc[ai][bj][2 + mm][1];
                        u32x4 w; w.x = pk2(v0[0], v0[1]); w.y = pk2(v0[2], v0[3]); w.z = pk2(v1[0], v1[1]); w.w = pk2(v1[2], v1[3]);
                        *(u32x4*)(HALO + ((size_t)(seg * 4 + m) * 2 + bj) * DFF + colj) = w; } }
            }
        }
    }
};
__device__ __forceinline__ void phase_fixup(const Args& a) {
    const bf16_t* halo = (const bf16_t*)(a.ws + WS_HALO); bf16_t* act = (bf16_t*)(a.ws + WS_ACT);
    const float* fw = a.in[13]; const float* fb = a.in[14];
    const int total = 512 * 2 * 352;
    for (int it = blockIdx.x * NT + threadIdx.x; it < total; it += gridDim.x * NT) {
        const int p = it % 352, rs = it / 352, rho = rs & 1, seg = rs >> 1, j0 = p * 8; const bool first = (seg & 31) == 0; const size_t t = (size_t)seg * 64 + rho;
        float o[2][8];
#pragma unroll
        for (int bj = 0; bj < 2; ++bj) { const int col = bj * DFF + j0;
            float cur[8], m1[8], m2[8];
            unpack8(*(const u32x4*)(halo + ((size_t)(seg * 4 + rho) * 2 + bj) * DFF + j0), cur);
#pragma unroll
            for (int e = 0; e < 8; ++e) { m1[e] = 0.f; m2[e] = 0.f; }
            if (rho == 1) { unpack8(*(const u32x4*)(halo + ((size_t)(seg * 4 + 0) * 2 + bj) * DFF + j0), m1);
                if (!first) unpack8(*(const u32x4*)(halo + ((size_t)((seg - 1) * 4 + 3) * 2 + bj) * DFF + j0), m2); }
            else if (!first) { unpack8(*(const u32x4*)(halo + ((size_t)((seg - 1) * 4 + 3) * 2 + bj) * DFF + j0), m1);
                unpack8(*(const u32x4*)(halo + ((size_t)((seg - 1) * 4 + 2) * 2 + bj) * DFF + j0), m2); }
#pragma unroll
            for (int e = 0; e < 8; ++e) o[bj][e] = fb[col + e] + fw[2 * NUP + col + e] * cur[e] + fw[NUP + col + e] * m1[e] + fw[col + e] * m2[e];
        }
        float r8[8];
#pragma unroll
        for (int e = 0; e < 8; ++e) r8[e] = siluf_(o[0][e]) * o[1][e];
        *(u32x4*)(act + t * DFF + j0) = pack8(r8);
    }
}
#define GAS __attribute__((address_space(1)))
struct TileDesc { const float* W; bf16_t* WT; const float* ks; int ldw, K, k0, n0, src; };
constexpr int TW_IN = 8 * 40, TW_OUT = 8 * 16, TW_UP = 8 * 88, TW_DN = 22 * 16, TW_PW = 4 * 2;
constexpr int TW_A = TW_IN, TW_B = TW_A + TW_PW, TW_END = TW_B + TW_OUT + TW_UP + TW_DN;
__device__ __forceinline__ TileDesc tile_desc(const Args& a, int it) {
    TileDesc t; int r = it; t.ks = nullptr;
    if (r < TW_IN) { const int kb = r / 40, nb = r % 40, n0 = nb * 64; t.W = a.in[2]; t.ldw = 2568; t.WT = (bf16_t*)(a.ws + WS_WIN); t.K = 1024; t.k0 = kb * 128; t.n0 = n0; t.src = n0 < 2048 ? n0 : n0 + 8; t.ks = a.in[1]; return t; }
    r -= TW_IN;
    if (r < TW_PW) { const int kb = r / 2, nb = r % 2; t.W = a.in[7]; t.ldw = 128; t.WT = (bf16_t*)(a.ws + WS_PWT); t.K = 512; t.k0 = kb * 128; t.n0 = nb * 64; t.src = nb * 64; return t; }
    r -= TW_PW;
    if (r < TW_OUT) { const int kb = r / 16, nb = r % 16; t.W = a.in[10]; t.ldw = 1024; t.WT = (bf16_t*)(a.ws + WS_WOUT); t.K = 1024; t.k0 = kb * 128; t.n0 = nb * 64; t.src = nb * 64; return t; }
    r -= TW_OUT;
    if (r < TW_UP) { const int kb = r / 88, nb = r % 88, n0 = nb * 64, pn = n0 >> 8, rr = n0 & 255; t.W = a.in[12]; t.ldw = NUP; t.WT = (bf16_t*)(a.ws + WS_WUP); t.K = 1024; t.k0 = kb * 128; t.n0 = n0;
        t.src = (rr >> 7) * DFF + pn * 128 + (rr & 127); t.ks = a.in[11]; return t; }
    r -= TW_UP;
    { const int kb = r / 16, nb = r % 16; t.W = a.in[15]; t.ldw = 1024; t.WT = (bf16_t*)(a.ws + WS_WDOWN); t.K = DFF; t.k0 = kb * 128; t.n0 = nb * 64; t.src = nb * 64; return t; }
}
__device__ __forceinline__ void tile_load(const TileDesc& t, float (&v)[16]) {
    const int tid = threadIdx.x;
#pragma unroll
    for (int i = 0; i < 16; ++i) { const int kk = i * 8 + (tid >> 6), j = tid & 63; v[i] = t.W[(size_t)(t.k0 + kk) * t.ldw + t.src + j]; }
    if (t.ks) { float sc[16];
#pragma unroll
        for (int i = 0; i < 16; ++i) sc[i] = t.ks[t.k0 + i * 8 + (tid >> 6)];
#pragma unroll
        for (int i = 0; i < 16; ++i) v[i] *= sc[i]; }
}
__device__ __forceinline__ void phase_weights(const Args& a, PG8_LAS float* tile, int lo, int NTILES, int bid, int nb) {
    const int tid = threadIdx.x;
    int it = lo + bid; if (it >= NTILES) return;
    TileDesc cur = tile_desc(a, it); float v[16]; tile_load(cur, v);
    for (;;) {
#pragma unroll
        for (int i = 0; i < 16; ++i) tile[(i * 8 + (tid >> 6)) * 65 + (tid & 63)] = v[i];
        __syncthreads();
        const int nit = it + nb; const bool more = nit < NTILES; TileDesc nx = cur;
        if (more) { nx = tile_desc(a, nit); tile_load(nx, v); }
#pragma unroll
        for (int hh = 0; hh < 2; ++hh) { const int pidx = tid + 512 * hh, j = pidx >> 4, c = pidx & 15; const PG8_LAS float* s = tile + (8 * c) * 65 + j;
          u32x4 o; o.x = pk2(s[0], s[65]); o.y = pk2(s[130], s[195]); o.z = pk2(s[260], s[325]); o.w = pk2(s[390], s[455]);
          *(u32x4*)(cur.WT + (size_t)(cur.n0 + j) * cur.K + cur.k0 + 8 * c) = o; }
        __syncthreads();
        if (!more) break;
        cur = nx; it = nit;
    }
}
__device__ __forceinline__ void phase_norm1(const Args& a, float* wba) {
    const int tid = threadIdx.x, lane = tid & 63, wave = tid >> 6;
    const float* x = a.in[0]; const float* nw1 = a.in[1]; const float* w_in = a.in[2];
    bf16_t* h1b = (bf16_t*)a.out; float* rs1 = (float*)(a.ws + WS_RS1); float* betaB = (float*)(a.ws + WS_BETA); float* gB = (float*)(a.ws + WS_G);
    for (int k = tid; k < 1024; k += NT) { const float nw = nw1[k];
#pragma unroll
        for (int c = 0; c < 8; ++c) wba[c * 1024 + k] = w_in[(size_t)k * 2568 + 2048 + c] * nw; }
    __syncthreads();
    const int hh = (lane >> 3) & 3; const float alog = a.in[4][hh], dtb = a.in[5][hh]; const float aexp = -__expf(alog);
    f32x4 nwv[4];
#pragma unroll
    for (int j = 0; j < 4; ++j) nwv[j] = *(const f32x4*)(nw1 + 256 * j + 4 * lane);
    for (int row = blockIdx.x * 8 + wave; row < M; row += gridDim.x * 8) {
        const f32x4* xr = (const f32x4*)(x + (size_t)row * 1024) + lane;
        f32x4 v[4]; float ss = 0.f;
#pragma unroll
        for (int j = 0; j < 4; ++j) { v[j] = xr[64 * j]; ss += (v[j][0] * v[j][0] + v[j][1] * v[j][1]) + (v[j][2] * v[j][2] + v[j][3] * v[j][3]); }
        ss = wave_sum(ss); const float rstd = rsqrtf(ss * (1.0f / 1024.0f) + EPS);
        float d[8];
#pragma unroll
        for (int c = 0; c < 8; ++c) { float s = 0.f;
#pragma unroll
            for (int j = 0; j < 4; ++j) { const f32x4 w = *(const f32x4*)(wba + c * 1024 + 256 * j + 4 * lane); s += (v[j][0] * w[0] + v[j][1] * w[1]) + (v[j][2] * w[2] + v[j][3] * w[3]); }
            d[c] = s; }
        float dsum;
        { const bool b5 = lane & 32, b4 = lane & 16, b3 = lane & 8; float r4[4], r2[2];
#pragma unroll
          for (int i = 0; i < 4; ++i) { const float snd = b5 ? d[i] : d[4 + i], kp = b5 ? d[4 + i] : d[i]; r4[i] = kp + __shfl_xor(snd, 32); }
#pragma unroll
          for (int i = 0; i < 2; ++i) { const float snd = b4 ? r4[i] : r4[2 + i], kp = b4 ? r4[2 + i] : r4[i]; r2[i] = kp + __shfl_xor(snd, 16); }
          { const float snd = b3 ? r2[0] : r2[1], kp = b3 ? r2[1] : r2[0]; dsum = kp + __shfl_xor(snd, 8); }
          dsum += __shfl_xor(dsum, 4); dsum += __shfl_xor(dsum, 2); dsum += __shfl_xor(dsum, 1); dsum *= rstd; }
        bf16_t* hr = h1b + (size_t)row * 1024 + 4 * lane;
#pragma unroll
        for (int j = 0; j < 4; ++j) { const f32x4 h = v[j]; u32x2 w; w.x = pk2(h[0], h[1]); w.y = pk2(h[2], h[3]); *(u32x2*)(hr + 256 * j) = w; }
        if (lane == 0) rs1[row] = rstd;
        if ((lane & 7) == 0) { const int c = lane >> 3;
            if (c < 4) betaB[(size_t)row * 4 + c] = sigmoidf_(dsum);
            else { const float z = dsum + dtb; const float sp = z > 20.f ? z : log1pf(__expf(z)); gB[(size_t)row * 4 + (c - 4)] = aexp * sp; } }
    }
}

__device__ __forceinline__ void phase_qkv(const Args& a) {
    const int tid = threadIdx.x, lane = tid & 63, wave = tid >> 6;
    const bf16_t* proj = (const bf16_t*)(a.ws + WS_PROJ); const float* cw = a.in[3];
    for (int item = blockIdx.x * 8 + wave; item < 6144; item += gridDim.x * 8) {
        const int part = item % 3, rg = item / 3, rowA = rg * 16, pos0 = rowA & 2047, ch0 = part * 512 + 8 * lane;
        float w[4][8];
#pragma unroll
        for (int i = 0; i < 4; ++i) { const f32x4 w0 = *(const f32x4*)(cw + i * 1536 + ch0), w1 = *(const f32x4*)(cw + i * 1536 + ch0 + 4);
            w[i][0] = w0[0]; w[i][1] = w0[1]; w[i][2] = w0[2]; w[i][3] = w0[3]; w[i][4] = w1[0]; w[i][5] = w1[1]; w[i][6] = w1[2]; w[i][7] = w1[3]; }
        u32x4 R[19];
#pragma unroll
        for (int j = 0; j < 19; ++j) { const int dr = j - 3; const int rr = (pos0 + dr >= 0) ? rowA + dr : rowA; R[j] = *(const u32x4*)(proj + (size_t)rr * NPROJ + ch0); }
        bf16_t* dst = (bf16_t*)(a.ws + (part == 0 ? WS_QB : WS_KB)) + (size_t)rowA * 512 + 8 * lane;
        const float qsc = (part == 0) ? 0.08838834764831845f : 1.0f;
        u32x4 yb[16]; float F[19][8];
#pragma unroll
        for (int m = 0; m < 16; ++m) {
            float acc[8];
#pragma unroll
            for (int e = 0; e < 8; ++e) acc[e] = 0.f;
            if (m == 0) { unpack8(R[0], F[0]); unpack8(R[1], F[1]); unpack8(R[2], F[2]); }
            unpack8(R[m + 3], F[m + 3]);
#pragma unroll
            for (int i = 0; i < 4; ++i) {
                if (m + i < 3) { const float vm = (pos0 + m + i - 3 >= 0) ? 1.0f : 0.0f;
#pragma unroll
                    for (int e = 0; e < 8; ++e) acc[e] += F[m + i][e] * (w[i][e] * vm); }
                else {
#pragma unroll
                    for (int e = 0; e < 8; ++e) acc[e] += F[m + i][e] * w[i][e]; } }
            float ssq = 0.f;
#pragma unroll
            for (int e = 0; e < 8; ++e) { acc[e] = siluf_(acc[e]); ssq += acc[e] * acc[e]; }
            if (part < 2) { ssq = sum16(ssq); const float sc = rsqrtf(ssq + EPS) * qsc;
#pragma unroll
                for (int e = 0; e < 8; ++e) acc[e] *= sc; }
            yb[m] = pack8(acc);
            if (part < 2) *(u32x4*)(dst + (size_t)m * 512) = yb[m];
        }
        if (part > 0) {
            bf16_t* tb = (bf16_t*)(a.ws + (part == 1 ? WS_KT : WS_VT)) + ((size_t)(rg >> 2) * 512 + 8 * lane) * 64 + (rg & 3) * 16;
#pragma unroll
            for (int e = 0; e < 8; ++e) { u32x4 o0, o1;
#pragma unroll
                for (int pp = 0; pp < 8; ++pp) { const unsigned A = yb[2 * pp][e >> 1], B = yb[2 * pp + 1][e >> 1];
                    const unsigned v = (e & 1) ? ((A >> 16) | (B & 0xffff0000u)) : ((A & 0xffffu) | (B << 16));
                    if (pp < 4) o0[pp] = v; else o1[pp - 4] = v; }
                *(u32x4*)(tb + e * 64) = o0; *(u32x4*)(tb + e * 64 + 8) = o1; }
        }
    }
}
typedef pg8::bf16x8 bf16x8;
#define MFMA16(a, b, c) __builtin_amdgcn_mfma_f32_16x16x32_bf16((a), (b), (c), 0, 0, 0)
constexpr size_t WS_GL = 27 * MBY, WS_PREP = 352 * MBY, WS_OF2 = 256 * MBY;
constexpr int PREP_ITEM = 73728, PI_W = 0, PI_QG = 16384, PI_KD = 32768, PI_UT = 49152, PI_AQ = 65536;
__host__ __device__ __forceinline__ constexpr int perm32s(int o) { return 8 * ((o >> 2) & 3) + 4 * (o >> 4) + (o & 3); }
__host__ __device__ __forceinline__ constexpr int tokofpos(int p) { return (p & 32) + 16 * ((p & 7) >> 2) + 4 * ((p >> 3) & 3) + (p & 3); }
__device__ __forceinline__ bf16x8 packf8(const f32x4 lo, const f32x4 hi) { u32x4 p; p.x = pk2(lo[0], lo[1]); p.y = pk2(lo[2], lo[3]); p.z = pk2(hi[0], hi[1]); p.w = pk2(hi[2], hi[3]); return __builtin_bit_cast(bf16x8, p); }
__device__ __forceinline__ bf16_t f2bf(float x) { return (bf16_t)(pk2(x, x) & 0xffffu); }
__device__ __forceinline__ float bf2f(bf16_t x) { return __uint_as_float(((unsigned)x) << 16); }

__device__ __forceinline__ void solve64(float (&x)[64], const PG8_LAS float* sLt) {
    f32x4 cur[16];
#pragma unroll
    for (int i4 = 0; i4 < 16; ++i4) cur[i4] = *(const PG8_LAS f32x4*)(sLt + 4 * i4);
    asm volatile("" ::: "memory");
#pragma unroll
    for (int j = 0; j < 63; ++j) {
        const float xj = x[j];
#pragma unroll
        for (int i4 = (j + 1) / 4; i4 < 16; ++i4) {
            if (4 * i4 + 0 > j) x[4 * i4 + 0] -= cur[i4][0] * xj;
            if (4 * i4 + 1 > j) x[4 * i4 + 1] -= cur[i4][1] * xj;
            if (4 * i4 + 2 > j) x[4 * i4 + 2] -= cur[i4][2] * xj;
            if (4 * i4 + 3 > j) x[4 * i4 + 3] -= cur[i4][3] * xj;
            if (j + 1 < 63 && i4 >= (j + 2) / 4) cur[i4] = *(const PG8_LAS f32x4*)(sLt + (j + 1) * 64 + 4 * i4); }
        asm volatile("" ::: "memory");
    }
}

__device__ __forceinline__ void phase_prep(const Args& a, PG8_LAS unsigned char* lds) {
    const int tid = threadIdx.x, lane = tid & 63, wave = __builtin_amdgcn_readfirstlane(tid >> 6), half = wave >> 2, lw = wave & 3, q = lane >> 4, r = lane & 15;
    const int role = (lw - half) & 3;
    PG8_LAS unsigned char* hb = lds + half * 36864;
    PG8_LAS float* sG = (PG8_LAS float*)hb; PG8_LAS float* sB = sG + 64; PG8_LAS float* sE = sG + 128; PG8_LAS float* sK = sG + 192; PG8_LAS float* sL = sG + 256;
    PG8_LAS unsigned char* Tu = hb + 17408; PG8_LAS unsigned char* Tw = Tu + 9216;
    const bf16_t* qb = (const bf16_t*)(a.ws + WS_QB); const bf16_t* kb = (const bf16_t*)(a.ws + WS_KB);
    const bf16_t* kT = (const bf16_t*)(a.ws + WS_KT); const bf16_t* vT = (const bf16_t*)(a.ws + WS_VT);
    const float* betaB = (const float*)(a.ws + WS_BETA); const float* gB = (const float*)(a.ws + WS_G); float* glast = (float*)(a.ws + WS_GL);
    for (int unit = blockIdx.x; unit < 1024; unit += gridDim.x) {
        const int hp = unit & 1, bn = unit >> 1, h = 2 * hp + half, item = bn * 4 + h; const size_t r0 = (size_t)bn * 64;
        unsigned char* pi = a.ws + WS_PREP + (size_t)item * PREP_ITEM;
        bf16_t* wp = (bf16_t*)(pi + PI_W); bf16_t* qgp = (bf16_t*)(pi + PI_QG); bf16_t* kdTp = (bf16_t*)(pi + PI_KD); bf16_t* uT = (bf16_t*)(pi + PI_UT); bf16_t* aqkp = (bf16_t*)(pi + PI_AQ);
        const bf16_t* qbase = qb + r0 * 512 + h * 128; const bf16_t* kbase = kb + r0 * 512 + h * 128;
        const bf16_t* kTb = kT + ((size_t)bn * 512 + h * 128) * 64; const bf16_t* vTb = vT + ((size_t)bn * 512 + h * 128) * 64;
        bf16x8 ak[4], aq[4], bkf[2][4];
#pragma unroll
        for (int s = 0; s < 4; ++s) { ak[s] = *(const bf16x8*)(kbase + (size_t)(16 * lw + r) * 512 + 32 * s + 8 * q); aq[s] = *(const bf16x8*)(qbase + (size_t)(16 * lw + r) * 512 + 32 * s + 8 * q); }
#pragma unroll
        for (int tj = 0; tj < 2; ++tj)
#pragma unroll
            for (int s = 0; s < 4; ++s) bkf[tj][s] = *(const bf16x8*)(kbase + (size_t)(16 * tj + r) * 512 + 32 * s + 8 * q);
        bf16x8 pv[2][2], pk[2][2];
        if (role != 0) {
#pragma unroll
        for (int cc = 0; cc < 2; ++cc) { const int ct = 2 * lw + cc;
            pv[cc][0] = *(const bf16x8*)(vTb + (size_t)(16 * ct + r) * 64 + 8 * q); pv[cc][1] = *(const bf16x8*)(vTb + (size_t)(16 * ct + r) * 64 + 32 + 8 * q);
            pk[cc][0] = *(const bf16x8*)(kTb + (size_t)(16 * ct + r) * 64 + 8 * q); pk[cc][1] = *(const bf16x8*)(kTb + (size_t)(16 * ct + r) * 64 + 32 + 8 * q); } }
        float gv = gB[(r0 + lane) * 4 + h];
#pragma unroll
        for (int off = 1; off < 64; off <<= 1) { const float t = __shfl_up(gv, off); if (lane >= off) gv += t; }
        const float g63 = __shfl(gv, 63);
        if (lw == 0) { sG[lane] = gv; sB[lane] = betaB[(r0 + lane) * 4 + h]; sE[lane] = __expf(gv); sK[lane] = __expf(g63 - gv); }
        if ((tid & 255) == 0) glast[item] = __expf(g63);
        __syncthreads();
        {
#pragma unroll
            for (int tj = 0; tj < 4; ++tj) {
                f32x4 ckk = {0.f, 0.f, 0.f, 0.f}, cqk = {0.f, 0.f, 0.f, 0.f};
#pragma unroll
                for (int s = 0; s < 4; ++s) { const bf16x8 bk = (tj < 2) ? bkf[tj & 1][s] : *(const bf16x8*)(kbase + (size_t)(16 * tj + r) * 512 + 32 * s + 8 * q); ckk = MFMA16(ak[s], bk, ckk); cqk = MFMA16(aq[s], bk, cqk); }
                const int j = 16 * tj + r; const float Gj = sG[j]; const int jpos = (j & 32) + perm32s(j & 31);
                f32x4 lv;
#pragma unroll
                for (int e = 0; e < 4; ++e) { const int i = 16 * lw + 4 * q + e; const float Gi = sG[i], bi = sB[i];
                    const float dec = (i >= j) ? __expf(Gi - Gj) : 0.f;
                    lv[e] = (i > j) ? ckk[e] * bi * dec : 0.f;
                    aqkp[i * 64 + jpos] = f2bf((i >= j) ? cqk[e] * dec : 0.f); }
                *(PG8_LAS f32x4*)(sL + j * 64 + 16 * lw + 4 * q) = lv;
            }
        }
        __syncthreads();
        if (role == 0) {
            float x[64];
#pragma unroll
            for (int i = 0; i < 64; ++i) x[i] = (i == lane) ? 1.0f : 0.0f;
            __builtin_amdgcn_s_setprio(3);
            solve64(x, sL);
            __builtin_amdgcn_s_setprio(0);
#pragma unroll
            for (int cc = 0; cc < 2; ++cc) { const int ct = 2 * lw + cc;
                pv[cc][0] = *(const bf16x8*)(vTb + (size_t)(16 * ct + r) * 64 + 8 * q); pv[cc][1] = *(const bf16x8*)(vTb + (size_t)(16 * ct + r) * 64 + 32 + 8 * q);
                pk[cc][0] = *(const bf16x8*)(kTb + (size_t)(16 * ct + r) * 64 + 8 * q); pk[cc][1] = *(const bf16x8*)(kTb + (size_t)(16 * ct + r) * 64 + 32 + 8 * q); }
            const float bj = sB[lane], bej = bj * sE[lane];
#pragma unroll
            for (int i = 0; i < 64; ++i) { *(PG8_LAS bf16_t*)(Tu + (i * 72 + lane) * 2) = f2bf(x[i] * bj); *(PG8_LAS bf16_t*)(Tw + (i * 72 + lane) * 2) = f2bf(x[i] * bej); }
        } else if (role == 1) {
#pragma unroll 4
            for (int k = 0; k < 16; ++k) { const int pidx = lane + 64 * k, i = pidx >> 4, pc = pidx & 15, aa = pc & 3, c32 = (pc >> 2) * 32;
                float f[8]; unpack8(*(const u32x4*)(qbase + (size_t)i * 512 + pc * 8), f); const float e = sE[i];
                u32x2 lo, hi; lo.x = pk2(f[0] * e, f[1] * e); lo.y = pk2(f[2] * e, f[3] * e); hi.x = pk2(f[4] * e, f[5] * e); hi.y = pk2(f[6] * e, f[7] * e);
                *(u32x2*)(qgp + i * 128 + c32 + 8 * ((2 * aa) & 3) + 4 * (aa >> 1)) = lo;
                *(u32x2*)(qgp + i * 128 + c32 + 8 * ((2 * aa + 1) & 3) + 4 * (aa >> 1)) = hi; }
        } else {
            const int d = (role - 2) * 64 + lane; float x[64];
#pragma unroll
            for (int c8 = 0; c8 < 8; ++c8) { float f[8]; unpack8(*(const u32x4*)(kTb + (size_t)d * 64 + 8 * c8), f);
#pragma unroll
                for (int e = 0; e < 8; ++e) x[8 * c8 + e] = f[e] * sK[8 * c8 + e]; }
#pragma unroll
            for (int c8 = 0; c8 < 8; ++c8) { u32x4 o;
                o.x = pk2(x[tokofpos(8 * c8 + 0)], x[tokofpos(8 * c8 + 1)]); o.y = pk2(x[tokofpos(8 * c8 + 2)], x[tokofpos(8 * c8 + 3)]);
                o.z = pk2(x[tokofpos(8 * c8 + 4)], x[tokofpos(8 * c8 + 5)]); o.w = pk2(x[tokofpos(8 * c8 + 6)], x[tokofpos(8 * c8 + 7)]);
                *(u32x4*)(kdTp + d * 64 + 8 * c8) = o; }
        }
        __syncthreads();
        {
            bf16x8 tf[4][2];
#pragma unroll
            for (int it = 0; it < 4; ++it)
#pragma unroll
                for (int s = 0; s < 2; ++s) tf[it][s] = *(const PG8_LAS bf16x8*)(Tu + ((16 * it + r) * 72 + 32 * s + 8 * q) * 2);
#pragma unroll
            for (int cc = 0; cc < 2; ++cc) { const int ct = 2 * lw + cc;
                const bf16x8 v0 = pv[cc][0], v1 = pv[cc][1];
#pragma unroll
                for (int it = 0; it < 4; ++it) { f32x4 acc = {0.f, 0.f, 0.f, 0.f}; acc = MFMA16(tf[it][0], v0, acc); acc = MFMA16(tf[it][1], v1, acc);
                    u32x2 w; w.x = pk2c(acc[0], acc[1]); w.y = pk2c(acc[2], acc[3]);
                    *(u32x2*)(uT + (16 * ct + r) * 64 + 16 * it + 4 * q) = w; } }
#pragma unroll
            for (int it = 0; it < 4; ++it)
#pragma unroll
                for (int s = 0; s < 2; ++s) tf[it][s] = *(const PG8_LAS bf16x8*)(Tw + ((16 * it + r) * 72 + 32 * s + 8 * q) * 2);
#pragma unroll
            for (int cc = 0; cc < 2; ++cc) { const int dt = 2 * lw + cc;
                const bf16x8 k0 = pk[cc][0], k1 = pk[cc][1];
                const int o4 = 16 * dt + 4 * q, dpos = (o4 & ~31) + perm32s(o4 & 31);
#pragma unroll
                for (int it = 0; it < 4; ++it) { f32x4 acc = {0.f, 0.f, 0.f, 0.f}; acc = MFMA16(k0, tf[it][0], acc); acc = MFMA16(k1, tf[it][1], acc);
                    u32x2 w; w.x = pk2c(acc[0], acc[1]); w.y = pk2c(acc[2], acc[3]);
                    *(u32x2*)(wp + (16 * it + r) * 128 + dpos) = w; } }
        }
        __syncthreads();
    }
}

__device__ __forceinline__ void phase_scan(const Args& a, PG8_LAS unsigned char* lds, int sblk) {
    const int tid = threadIdx.x, lane = tid & 63, wave = tid >> 6, q = lane >> 4, r = lane & 15;
    const int bh = sblk >> 1, dvh = sblk & 1, b = bh >> 2, h = bh & 3;
    bf16_t* of = (bf16_t*)(a.ws + WS_OF2); const float* glast = (const float*)(a.ws + WS_GL);
    constexpr int L_W = 0, L_QG = 17408, L_KD = 34816, L_UT = 53248, L_AQ = 71680;
    f32x4 S[8];
#pragma unroll
    for (int m = 0; m < 8; ++m) S[m] = (f32x4){0.f, 0.f, 0.f, 0.f};
    u32x4 pre[9];
    { const unsigned char* src = a.ws + WS_PREP + (size_t)((b * 32 + 0) * 4 + h) * PREP_ITEM;
#pragma unroll
      for (int i = 0; i < 9; ++i) pre[i] = __builtin_nontemporal_load((const u32x4*)(src + (size_t)(tid + 512 * i) * 16)); }
    for (int n = 0; n < 32; ++n) {
#pragma unroll
        for (int i = 0; i < 9; ++i) { const int p = tid + 512 * i; int off;
            if (i < 2) off = L_W + (p >> 4) * 272 + (p & 15) * 16;
            else if (i < 4) { const int pp = p - 1024; off = L_QG + (pp >> 4) * 272 + (pp & 15) * 16; }
            else if (i < 6) { const int pp = p - 2048; off = L_KD + (pp >> 3) * 144 + (pp & 7) * 16; }
            else if (i < 8) { const int pp = p - 3072; off = L_UT + (pp >> 3) * 144 + (pp & 7) * 16; }
            else { const int pp = p - 4096; off = L_AQ + (pp >> 3) * 144 + (pp & 7) * 16; }
            *(PG8_LAS u32x4*)(lds + off) = pre[i]; }
        __syncthreads();
        if (n + 1 < 32) { const unsigned char* src = a.ws + WS_PREP + (size_t)((b * 32 + n + 1) * 4 + h) * PREP_ITEM;
#pragma unroll
            for (int i = 0; i < 9; ++i) pre[i] = __builtin_nontemporal_load((const u32x4*)(src + (size_t)(tid + 512 * i) * 16)); }
        if (wave < 4) {
            __builtin_amdgcn_s_setprio(2);
            const int dv0 = dvh * 64 + wave * 16; const float gl = glast[(b * 32 + n) * 4 + h]; const size_t row0 = (size_t)b * 2048 + n * 64;
            bf16x8 Sb[4];
#pragma unroll
            for (int s = 0; s < 4; ++s) Sb[s] = packf8(S[2 * s], S[2 * s + 1]);
            f32x4 vn[4];
#pragma unroll
            for (int mt = 0; mt < 4; ++mt) {
                const u32x2 uu = *(const PG8_LAS u32x2*)(lds + L_UT + (dv0 + r) * 144 + (16 * mt + 4 * q) * 2);
                f32x4 acc = {0.f, 0.f, 0.f, 0.f};
#pragma unroll
                for (int s = 0; s < 4; ++s) { const bf16x8 af = *(const PG8_LAS bf16x8*)(lds + L_W + (16 * mt + r) * 272 + (32 * s + 8 * q) * 2); acc = MFMA16(af, Sb[s], acc); }
                vn[mt] = (f32x4){bf_lo(uu.x), bf_hi(uu.x), bf_lo(uu.y), bf_hi(uu.y)} - acc;
            }
            bf16x8 Vb[2];
#pragma unroll
            for (int s = 0; s < 2; ++s) Vb[s] = packf8(vn[2 * s], vn[2 * s + 1]);
#pragma unroll
            for (int mt = 0; mt < 4; ++mt) {
                f32x4 o = {0.f, 0.f, 0.f, 0.f};
#pragma unroll
                for (int s = 0; s < 4; ++s) { const bf16x8 af = *(const PG8_LAS bf16x8*)(lds + L_QG + (16 * mt + r) * 272 + (32 * s + 8 * q) * 2); o = MFMA16(af, Sb[s], o); }
#pragma unroll
                for (int s = 0; s < 2; ++s) { const bf16x8 af = *(const PG8_LAS bf16x8*)(lds + L_AQ + (16 * mt + r) * 144 + (32 * s + 8 * q) * 2); o = MFMA16(af, Vb[s], o); }
#pragma unroll
                for (int e = 0; e < 4; ++e) of[(row0 + 16 * mt + 4 * q + e) * 512 + h * 128 + dv0 + r] = (bf16_t)(pk2c(o[e], o[e]) & 0xffffu);
            }
#pragma unroll
            for (int mt = 0; mt < 8; ++mt) {
                f32x4 acc = S[mt] * gl;
#pragma unroll
                for (int s = 0; s < 2; ++s) { const bf16x8 af = *(const PG8_LAS bf16x8*)(lds + L_KD + (16 * mt + r) * 144 + (32 * s + 8 * q) * 2); acc = MFMA16(af, Vb[s], acc); }
                S[mt] = acc;
            }
            __builtin_amdgcn_s_setprio(0);
        }
        __syncthreads();
    }
}
template <int WIN>
__device__ __forceinline__ void pool_fill(const bf16_t* proj, PG8_LAS unsigned char* lds, int row0, int gi) {
    const int tid = threadIdx.x, pc = tid & 15, tr = tid >> 4, tok0 = 4 * tr, rowA = row0 + tok0, pos0 = rowA & 2047;
    constexpr int NR = WIN + 3;
    u32x4 R[NR];
    const bf16_t* base = proj + 2048 + gi * 128 + pc * 8;
#pragma unroll
    for (int j = 0; j < NR; ++j) { const int dr = j - (WIN - 1); const int rr = (pos0 + dr >= 0) ? rowA + dr : rowA; R[j] = *(const u32x4*)(base + (size_t)rr * NPROJ); }
    float s[8];
#pragma unroll
    for (int e = 0; e < 8; ++e) s[e] = 0.f;
#pragma unroll
    for (int j = 0; j < WIN; ++j) { float f[8]; unpack8(R[j], f); const float vm = (pos0 + j - (WIN - 1) >= 0) ? 1.0f : 0.0f;
#pragma unroll
        for (int e = 0; e < 8; ++e) s[e] += vm * f[e]; }
#pragma unroll
    for (int m = 0; m < 4; ++m) {
        float u[8]; unpack8(R[WIN - 1 + m], u);
        if (m > 0) { float o[8]; unpack8(R[m - 1], o); const float vm = (pos0 + m - WIN >= 0) ? 1.0f : 0.0f;
#pragma unroll
            for (int e = 0; e < 8; ++e) s[e] += u[e] - vm * o[e]; }
        const int n = (pos0 + m + 1) < WIN ? (pos0 + m + 1) : WIN; const float inv = 1.0f / (float)n; float d[8];
#pragma unroll
        for (int e = 0; e < 8; ++e) d[e] = s[e] * inv - u[e];
        *(PG8_LAS u32x4*)(lds + (tok0 + m) * 272 + pc * 16) = pack8(d);
    }
}
__device__ __forceinline__ void phase_pool(const Args& a, PG8_LAS unsigned char* lds, int bid, int nb) {
    const int tid = threadIdx.x, lane = tid & 63, wave = tid >> 6, q = lane >> 4, r = lane & 15;
    const bf16_t* proj = (const bf16_t*)(a.ws + WS_PROJ); bf16_t* mix = (bf16_t*)(a.ws + WS_MIX); const bf16_t* pwt = (const bf16_t*)(a.ws + WS_PWT);
    const int gi = bid & 3;
    constexpr int L_WT = 34816, L_PB = L_WT + 128 * 272;
#pragma unroll
    for (int k = 0; k < 4; ++k) { const int idx = tid + 512 * k, row = idx >> 4, pc = idx & 15;
        *(PG8_LAS u32x4*)(lds + L_WT + row * 272 + pc * 16) = *(const u32x4*)(pwt + (size_t)row * 512 + gi * 128 + pc * 8); }
    if (tid < 128) { ((PG8_LAS float*)(lds + L_PB))[tid] = a.in[8][gi * 128 + tid]; ((PG8_LAS float*)(lds + L_PB))[128 + tid] = a.in[9][gi * 128 + tid]; }
    __syncthreads();
    for (int item = bid; item < 1024; item += nb) {
        const int tile = item >> 2, row0 = tile * 128;
        if (gi == 0) pool_fill<2>(proj, lds, row0, 0); else if (gi == 1) pool_fill<4>(proj, lds, row0, 1); else if (gi == 2) pool_fill<8>(proj, lds, row0, 2); else pool_fill<16>(proj, lds, row0, 3);
        __syncthreads();
        { bf16x8 df[4];
#pragma unroll
          for (int s = 0; s < 4; ++s) df[s] = *(const PG8_LAS bf16x8*)(lds + (16 * wave + r) * 272 + (32 * s + 8 * q) * 2);
#pragma unroll
          for (int nt = 0; nt < 8; ++nt) { f32x4 acc = {0.f, 0.f, 0.f, 0.f};
#pragma unroll
              for (int s = 0; s < 4; ++s) { const bf16x8 wf = *(const PG8_LAS bf16x8*)(lds + L_WT + (16 * nt + r) * 272 + (32 * s + 8 * q) * 2); acc = MFMA16(wf, df[s], acc); }
              const int dl = 16 * nt + 4 * q; const f32x4 o = (acc + *(const PG8_LAS f32x4*)(lds + L_PB + dl * 4)) * *(const PG8_LAS f32x4*)(lds + L_PB + 512 + dl * 4);
              u32x2 w; w.x = pk2(o[0], o[1]); w.y = pk2(o[2], o[3]);
              *(u32x2*)(mix + (size_t)(row0 + 16 * wave + r) * 1024 + 512 + gi * 128 + dl) = w; } }
        __syncthreads();
    }
}
__device__ __forceinline__ void phase_gate(const Args& a) {
    const int tid = threadIdx.x, lane = tid & 63, wave = tid >> 6;
    const bf16_t* proj = (const bf16_t*)(a.ws + WS_PROJ); const bf16_t* of = (const bf16_t*)(a.ws + WS_OF2); bf16_t* mix = (bf16_t*)(a.ws + WS_MIX);
    const float* onw = a.in[6]; const int c0 = (8 * lane) & 127;
    const f32x4 w0 = *(const f32x4*)(onw + c0), w1 = *(const f32x4*)(onw + c0 + 4);
    for (int row = blockIdx.x * 8 + wave; row < M; row += gridDim.x * 8) {
        float of8[8]; unpack8(*(const u32x4*)(of + (size_t)row * 512 + 8 * lane), of8);
        const f32x4 o0 = {of8[0], of8[1], of8[2], of8[3]}, o1 = {of8[4], of8[5], of8[6], of8[7]};
        float ss = (o0[0] * o0[0] + o0[1] * o0[1]) + (o0[2] * o0[2] + o0[3] * o0[3]) + (o1[0] * o1[0] + o1[1] * o1[1]) + (o1[2] * o1[2] + o1[3] * o1[3]);
        ss = sum16(ss); const float r = rsqrtf(ss * (1.0f / 128.0f) + EPS);
        float z[8]; unpack8(*(const u32x4*)(proj + (size_t)row * NPROJ + 1536 + 8 * lane), z);
        float y[8];
        y[0] = o0[0] * r * w0[0] * siluf_(z[0]); y[1] = o0[1] * r * w0[1] * siluf_(z[1]); y[2] = o0[2] * r * w0[2] * siluf_(z[2]); y[3] = o0[3] * r * w0[3] * siluf_(z[3]);
        y[4] = o1[0] * r * w1[0] * siluf_(z[4]); y[5] = o1[1] * r * w1[1] * siluf_(z[5]); y[6] = o1[2] * r * w1[2] * siluf_(z[6]); y[7] = o1[3] * r * w1[3] * siluf_(z[7]);
        *(u32x4*)(mix + (size_t)row * 1024 + 8 * lane) = pack8(y);
    }
}
__device__ __forceinline__ void phase_ffnconv(const Args& a, int hf) {
    const bf16_t* up = (const bf16_t*)(a.ws + WS_UPH); bf16_t* act = (bf16_t*)(a.ws + WS_ACT);
    const float* fw = a.in[13]; const float* fb = a.in[14];
    const int total = 16384 * 352;
    for (int it = blockIdx.x * NT + threadIdx.x; it < total; it += gridDim.x * NT) {
        const int rl = it / 352, p = it - rl * 352, j0 = p * 8, pn = j0 >> 7, jj = j0 & 127, row = hf * 16384 + rl, t = row & 2047, gcol = 256 * pn + jj;
        float g[8], v[8];
        { const f32x4 b0 = *(const f32x4*)(fb + j0), b1 = *(const f32x4*)(fb + j0 + 4), c0 = *(const f32x4*)(fb + DFF + j0), c1 = *(const f32x4*)(fb + DFF + j0 + 4);
          g[0] = b0[0]; g[1] = b0[1]; g[2] = b0[2]; g[3] = b0[3]; g[4] = b1[0]; g[5] = b1[1]; g[6] = b1[2]; g[7] = b1[3];
          v[0] = c0[0]; v[1] = c0[1]; v[2] = c0[2]; v[3] = c0[3]; v[4] = c1[0]; v[5] = c1[1]; v[6] = c1[2]; v[7] = c1[3]; }
#pragma unroll
        for (int i = 0; i < 3; ++i) { if (t - 2 + i >= 0) {
            float gf[8], vf[8]; unpack8(*(const u32x4*)(up + (size_t)(rl - 2 + i) * NUP + gcol), gf); unpack8(*(const u32x4*)(up + (size_t)(rl - 2 + i) * NUP + gcol + 128), vf);
            const float* wg = fw + (size_t)i * NUP + j0; const float* wv = wg + DFF;
            const f32x4 a0 = *(const f32x4*)wg, a1 = *(const f32x4*)(wg + 4), e0 = *(const f32x4*)wv, e1 = *(const f32x4*)(wv + 4);
            g[0] += gf[0] * a0[0]; g[1] += gf[1] * a0[1]; g[2] += gf[2] * a0[2]; g[3] += gf[3] * a0[3]; g[4] += gf[4] * a1[0]; g[5] += gf[5] * a1[1]; g[6] += gf[6] * a1[2]; g[7] += gf[7] * a1[3];
            v[0] += vf[0] * e0[0]; v[1] += vf[1] * e0[1]; v[2] += vf[2] * e0[2]; v[3] += vf[3] * e0[3]; v[4] += vf[4] * e1[0]; v[5] += vf[5] * e1[1]; v[6] += vf[6] * e1[2]; v[7] += vf[7] * e1[3]; } }
        float o[8];
#pragma unroll
        for (int e = 0; e < 8; ++e) o[e] = siluf_(g[e]) * v[e];
        *(u32x4*)(act + (size_t)row * DFF + j0) = pack8(o);
    }
}
__device__ __forceinline__ void phase_final(const Args& a) {
    const int tid = threadIdx.x, lane = tid & 63, wave = tid >> 6; const float* fw = a.in[16];
    const bf16_t* yb = (const bf16_t*)(a.ws + WS_YB); const float* ss3 = (const float*)(a.ws + WS_SS3);
    f32x4 nwv[4];
#pragma unroll
    for (int j = 0; j < 2; ++j) { nwv[2 * j] = *(const f32x4*)(fw + 512 * j + 8 * lane); nwv[2 * j + 1] = *(const f32x4*)(fw + 512 * j + 8 * lane + 4); }
    for (int row = blockIdx.x * 8 + wave; row < M; row += gridDim.x * 8) {
        const u32x4 y0 = *(const u32x4*)(yb + (size_t)row * 1024 + 8 * lane), y1 = *(const u32x4*)(yb + (size_t)row * 1024 + 512 + 8 * lane);
        const f32x4 s0 = *(const f32x4*)(ss3 + (size_t)row * 16), s1 = *(const f32x4*)(ss3 + (size_t)row * 16 + 4), s2 = *(const f32x4*)(ss3 + (size_t)row * 16 + 8), s3 = *(const f32x4*)(ss3 + (size_t)row * 16 + 12);
        const float ss = ((s0[0] + s0[1]) + (s0[2] + s0[3])) + ((s1[0] + s1[1]) + (s1[2] + s1[3])) + ((s2[0] + s2[1]) + (s2[2] + s2[3])) + ((s3[0] + s3[1]) + (s3[2] + s3[3]));
        const float rstd = rsqrtf(ss * (1.0f / 1024.0f) + EPS);
        float f0[8], f1[8]; unpack8(y0, f0); unpack8(y1, f1);
        float* op = a.out + (size_t)row * 1024 + 8 * lane;
        *(f32x4*)op = (f32x4){f0[0], f0[1], f0[2], f0[3]} * rstd * nwv[0]; *(f32x4*)(op + 4) = (f32x4){f0[4], f0[5], f0[6], f0[7]} * rstd * nwv[1];
        *(f32x4*)(op + 512) = (f32x4){f1[0], f1[1], f1[2], f1[3]} * rstd * nwv[2]; *(f32x4*)(op + 516) = (f32x4){f1[4], f1[5], f1[6], f1[7]} * rstd * nwv[3];
    }
}

#define XB_TMO      128
#define XB_XCNT(j)  (256  + 64 * (j))
#define XB_XSUB(j)  (1280 + 64 * (j))
#define XB_XGEN(j)  (2304 + 64 * (j))
#define XB_TOP      3328
#define XB_TOPGEN   3392
#define XCD_BAR_WORDS 3456
#define XB_SPIN_CAP (1u << 18)
#define LAS __attribute__((address_space(3)))

__device__ __forceinline__ unsigned xb_ld(unsigned* p)              { return __hip_atomic_load(p, __ATOMIC_RELAXED, __HIP_MEMORY_SCOPE_AGENT); }
__device__ __forceinline__ unsigned xb_add(unsigned* p, unsigned v) { return __hip_atomic_fetch_add(p, v, __ATOMIC_RELAXED, __HIP_MEMORY_SCOPE_AGENT); }
__device__ __forceinline__ unsigned xb_xcc_id() { return (unsigned)__builtin_amdgcn_s_getreg((3 << 11) | 20) & 0xFu; }
#define XB_SPIN(cond, bar) do { unsigned _sp = 0; while (cond) { __builtin_amdgcn_s_sleep(1); \
    if ((++_sp & 255u) == 0u) { if (xb_ld(&(bar)[XB_TMO])) break; if (_sp > XB_SPIN_CAP) { atomicAdd(&(bar)[XB_TMO], 1u); break; } } } } while (0)

struct XcdBarrier {
    unsigned* bar; unsigned x;
    volatile LAS unsigned* st;
};

__device__ __forceinline__ XcdBarrier xcd_barrier_post(unsigned* bar, volatile LAS unsigned* st) {
    XcdBarrier b; b.bar = bar; b.x = xb_xcc_id(); b.st = st;
    if (threadIdx.x == 0) (void)xb_add(&bar[XB_XCNT(b.x)], 1u);
    return b;
}
__device__ __forceinline__ void xcd_barrier_complete(unsigned* bar, unsigned x, unsigned& nloc, unsigned& nx) {
    const unsigned G = gridDim.x * gridDim.y * gridDim.z;
    unsigned sum, cnt, mine, sp = 0u;
    for (;;) {
        sum = 0u; cnt = 0u; mine = 0u;
#pragma unroll
        for (unsigned j = 0; j < 16; ++j) { const unsigned c = xb_ld(&bar[XB_XCNT(j)]); sum += c; cnt += (c > 0u) ? 1u : 0u; mine = (j == x) ? c : mine; }
        if (sum == G) break;
        __builtin_amdgcn_s_sleep(1);
        if ((++sp & 255u) == 0u) { if (xb_ld(&bar[XB_TMO])) break; if (sp > XB_SPIN_CAP) { atomicAdd(&bar[XB_TMO], 1u); break; } }
    }
    nloc = mine > 0u ? mine : 1u; nx = cnt > 0u ? cnt : 1u;
}

__device__ __forceinline__ void xcd_barrier(const XcdBarrier& b) {
    asm volatile("s_waitcnt vmcnt(0)" ::: "memory");
    __syncthreads();
    if (threadIdx.x == 0) {
        unsigned* bar = b.bar;
        __builtin_amdgcn_s_waitcnt(0);
        unsigned nloc = b.st[0], nx = b.st[1];
        if (nloc == 0u) { xcd_barrier_complete(bar, b.x, nloc, nx); b.st[0] = nloc; b.st[1] = nx; }
        const unsigned old = xb_add(&bar[XB_XSUB(b.x)], 1u);
        const unsigned gen = old / nloc;
        if (old + 1u == (gen + 1u) * nloc) {
            __builtin_amdgcn_fence(__ATOMIC_RELEASE, "agent");
            asm volatile("s_waitcnt vmcnt(0)" ::: "memory");
            const unsigned og = xb_add(&bar[XB_TOP], 1u);
            const unsigned tg = og / nx;
            if (og + 1u == (tg + 1u) * nx) xb_add(&bar[XB_TOPGEN], 1u);
            else XB_SPIN(xb_ld(&bar[XB_TOPGEN]) == tg, bar);
            __builtin_amdgcn_fence(__ATOMIC_ACQUIRE, "agent");
            xb_add(&bar[XB_XGEN(b.x)], 1u);
            asm volatile("s_waitcnt vmcnt(0)" ::: "memory");
        } else {
            XB_SPIN(xb_ld(&bar[XB_XGEN(b.x)]) == gen, bar);
            __builtin_amdgcn_fence(__ATOMIC_ACQUIRE, "agent");
            asm volatile("s_waitcnt vmcnt(0)" ::: "memory");
        }
    }
    __syncthreads();
}


__global__ void __launch_bounds__(NT) mega(Args a) {
    extern __shared__ __attribute__((aligned(16))) unsigned char lds_raw[];
    cg::grid_group grid = cg::this_grid();
    PG8_LAS unsigned char* lds = (PG8_LAS unsigned char*)lds_raw;
    volatile LAS unsigned* xst = (volatile LAS unsigned*)(lds + 131072);
    if (threadIdx.x < 4) xst[threadIdx.x] = 0u;
    __syncthreads();
    if (blockIdx.x == 0) { unsigned* bw = (unsigned*)(a.ws + WS_BAR); for (int i = threadIdx.x; i < XCD_BAR_WORDS; i += NT) bw[i] = 0u; }
    bf16_t* WinT = (bf16_t*)(a.ws + WS_WIN); bf16_t* WoutT = (bf16_t*)(a.ws + WS_WOUT); bf16_t* WupT = (bf16_t*)(a.ws + WS_WUP); bf16_t* WdownT = (bf16_t*)(a.ws + WS_WDOWN);
    bf16_t* h1b = (bf16_t*)a.out; bf16_t* proj = (bf16_t*)(a.ws + WS_PROJ); bf16_t* mix = (bf16_t*)(a.ws + WS_MIX); bf16_t* xb = (bf16_t*)(a.ws + WS_XB);
    bf16_t* uph = (bf16_t*)(a.ws + WS_UPH); bf16_t* act = (bf16_t*)(a.ws + WS_ACT); float* ss2 = (float*)(a.ws + WS_SS2);

    const unsigned mk = a.mask;
    if (mk & 1u) { phase_weights(a, (PG8_LAS float*)lds, 0, TW_B, (int)blockIdx.x, (int)gridDim.x); }
    __syncthreads();
    if (mk & 2048u) phase_norm1(a, (float*)lds_raw);
    grid.sync();
    XcdBarrier xbar = xcd_barrier_post((unsigned*)(a.ws + WS_BAR), xst);
    if (mk & 2u)
    { pg8::Gemm g{h1b, WinT, M, NPROJ, D}; pg8::StaticOrder S; S.init(M, NPROJ, (int)gridDim.x, (int)blockIdx.x); EpiBf16Plain E{proj, NPROJ, (const float*)(a.ws + WS_RS1)};
      pg8::gemm_phase<EpiBf16Plain, pg8::StaticOrder, true, true>(lds, g, S, E); }
    xcd_barrier(xbar);
    if (mk & 4u) phase_qkv(a);
    xcd_barrier(xbar);
    if (mk & 8u) phase_prep(a, lds);
    xcd_barrier(xbar);
    if (gridDim.x >= 256) { if (blockIdx.x < 128) { if (mk & 16u) phase_scan(a, lds, (int)blockIdx.x); } else if (mk & 4096u) { phase_pool(a, lds, (int)blockIdx.x - 128, (int)gridDim.x - 128); phase_weights(a, (PG8_LAS float*)lds, TW_B, TW_END, (int)blockIdx.x - 128, (int)gridDim.x - 128); } }
    else { if (mk & 16u) for (int sb = blockIdx.x; sb < 128; sb += gridDim.x) phase_scan(a, lds, sb); if (mk & 4096u) { phase_pool(a, lds, (int)blockIdx.x, (int)gridDim.x & ~3); phase_weights(a, (PG8_LAS float*)lds, TW_B, TW_END, (int)blockIdx.x, (int)gridDim.x); } }
    xcd_barrier(xbar);
    if (mk & 32u) phase_gate(a);
    xcd_barrier(xbar);
    if (mk & 64u)
    { pg8::Gemm g{mix, WoutT, M, D, D}; pg8::StaticOrder S; S.init(M, D, (int)gridDim.x, (int)blockIdx.x); EpiOutProj E{(const bf16_t*)a.out, xb, ss2};
      pg8::gemm_phase<EpiOutProj, pg8::StaticOrder, true, true>(lds, g, S, E); }
    xcd_barrier(xbar);
    if (mk & 128u)
    { pg8::Gemm g{xb, WupT, M, NUP, D}; pg8::StaticOrder S; S.init(M, NUP, (int)gridDim.x, (int)blockIdx.x); EpiUpFused E{act, (bf16_t*)(a.ws + WS_HALO), ss2, a.in[13], a.in[14], lds + 131072 + 256};
      pg8::gemm_phase<EpiUpFused, pg8::StaticOrder, true, true>(lds, g, S, E); }
    xcd_barrier(xbar);
    if (mk & 256u) phase_fixup(a);
    xcd_barrier(xbar);
    if (mk & 512u)
    { pg8::Gemm g{act, WdownT, M, D, DFF}; pg8::StaticOrder S; S.init(M, D, (int)gridDim.x, (int)blockIdx.x); EpiDown E{xb, (bf16_t*)(a.ws + WS_YB), (float*)(a.ws + WS_SS3)};
      pg8::gemm_phase<EpiDown, pg8::StaticOrder, true, true>(lds, g, S, E); }
    xcd_barrier(xbar);
    if (mk & 1024u) phase_final(a);
}

extern "C" void kernel_launch(void* const* d_in, const int* in_sizes, int n_in, void* d_out, int out_size, void* d_ws, size_t ws_size, hipStream_t stream) {
    static int grid_blocks = 0;
    if (!grid_blocks) {
        int dev = 0, cus = 0, per_cu = 0;
        (void)hipGetDevice(&dev);
        (void)hipDeviceGetAttribute(&cus, hipDeviceAttributeMultiprocessorCount, dev);
        (void)hipFuncSetAttribute((const void*)mega, hipFuncAttributeMaxDynamicSharedMemorySize, LDS_BYTES);
        (void)hipOccupancyMaxActiveBlocksPerMultiprocessor(&per_cu, (const void*)mega, NT, LDS_BYTES);
        if (per_cu < 1) { fprintf(stderr, "occupancy query says %d\n", per_cu); per_cu = 1; }
        if (per_cu > 1) per_cu = 1;
        grid_blocks = cus * per_cu;
        if (ws_size < WS_END) fprintf(stderr, "workspace too small: %zu < %zu\n", ws_size, (size_t)WS_END);
    }
    Args a{};
    for (int i = 0; i < 17; ++i) a.in[i] = (const float*)d_in[i];
    a.out = (float*)d_out; a.ws = (unsigned char*)d_ws;
    void* args[] = {&a};
#ifdef PROBE_MASK
    a.mask = PROBE_MASK;
    (void)hipLaunchCooperativeKernel((const void*)mega, dim3(grid_blocks), dim3(NT), args, LDS_BYTES, stream);
#endif
    a.mask = 0x1fffu;
    hipError_t e = hipLaunchCooperativeKernel((const void*)mega, dim3(grid_blocks), dim3(NT), args, LDS_BYTES, stream);
    if (e != hipSuccess) fprintf(stderr, "cooperative launch failed: %s (grid %d)\n", hipGetErrorString(e), grid_blocks);
}
```

```cpp
#include <hip/hip_runtime.h>
#include <hip/hip_cooperative_groups.h>
#include <cstdio>
namespace cg = cooperative_groups;
namespace pg8 {
#define PG8_LAS __attribute__((address_space(3)))
typedef unsigned short bf16_t;
typedef short bf16x8 __attribute__((ext_vector_type(8)));
typedef float f32x4 __attribute__((ext_vector_type(4)));
typedef unsigned u32x4 __attribute__((ext_vector_type(4)));
constexpr int BM = 256, BK = 64, HALF = 128, HTB = HALF * BK * 2  , STAGE_BYTES = 8 * HTB, NXCD = 8, WGM = 8;

__host__ __device__ __forceinline__ int lds_byte(int r, int c) { const int st = (r >> 4) * 2 + (c >> 5), rr = r & 15, cc = c & 31, ob = rr * 64 + cc * 2; return st * 1024 + (ob ^ (((ob >> 9) & 1) << 5)); }
__host__ __device__ __forceinline__ void stage_rc(int b, int& R, int& C) { const int st = b / 1024, sb = b % 1024, swz = sb ^ (((sb >> 9) & 1) << 5); R = (st >> 1) * 16 + swz / 64; C = (st & 1) * 32 + (swz % 64) / 2; }
__host__ __device__ __forceinline__ int perm32(int rho) { const int n = rho >> 4, i = rho & 15; return 8 * (i >> 2) + 4 * n + (i & 3); }

struct Unit { int pm, pn; };
struct Gemm { const bf16_t* A; const bf16_t* Bt; int M, N, K; };
struct StaticOrder {
    int nM, nN, nwg, G, c;
    __host__ __device__ void init(int M, int N, int G_, int c_) { nM = M / BM; nN = N / BM; nwg = nM * nN; G = G_; c = c_; }
    __host__ __device__ bool next(int i, Unit& u) const {
        const long L = (long)i * G + c; if (L >= nwg) return false;
        int wgid = (int)L; { const int q = nwg / NXCD, r = nwg % NXCD, xcd = wgid % NXCD, off = wgid / NXCD; wgid = (xcd < r ? xcd * (q + 1) : r * (q + 1) + (xcd - r) * q) + off; }
        const int nig = WGM * nN, gid = wgid / nig, fm = gid * WGM, gsz = (nM - fm) < WGM ? (nM - fm) : WGM;
        u.pm = fm + ((wgid % nig) % gsz); u.pn = (wgid % nig) / gsz; return true;
    }
    __device__ __forceinline__ void a_ready(const Unit&) const {}
    __device__ __forceinline__ void done(const Unit&) const {}
};
__device__ __forceinline__ unsigned cvt_pk_bf16(float lo, float hi) { unsigned r; asm volatile("v_cvt_pk_bf16_f32 %0, %1, %2" : "=v"(r) : "v"(lo), "v"(hi)); return r; }
template <class Epi, class Sched, bool ALIGN_EPI = false, bool SP2 = false>
__device__ __forceinline__ void gemm_phase(PG8_LAS unsigned char* lds, const Gemm g, const Sched& S, const Epi& E) {
    const int tid = threadIdx.x, wid = __builtin_amdgcn_readfirstlane(tid >> 6), lane = tid & 63, wr = wid >> 2, wc = wid & 3, fr = lane & 15, fq = lane >> 4;
    const int K = g.K, nt = K / BK;
    unsigned voffA[2], voffB[2];
#pragma unroll
    for (int i = 0; i < 2; ++i) { int R, C; stage_rc(tid * 16 + i * 8192, R, C); const int Rb = Epi::PERM ? ((R & ~31) + perm32(R & 31)) : R;
        const int Ra = Epi::PERMA ? ((R & 64) + 4 * (R & 15) + ((R >> 4) & 3)) : R; voffA[i] = (unsigned)(Ra * K + C) * 2u; voffB[i] = (unsigned)(Rb * K + C) * 2u; }
    const size_t kstep = (size_t)(BK * 2);
    const size_t hstep = (size_t)HALF * K * 2;
    const size_t tstep = 2 * hstep;
    const unsigned ldsw = (unsigned)wid * 1024u;
    const int aoff = lds_byte(wr * 64 + fr, fq * 8), boff = lds_byte(wc * 32 + fr, fq * 8);
#define PG8_SA(b, h) (((b) * 2 + (h)) * HTB)
#define PG8_SB(b, h) ((4 + (b) * 2 + (h)) * HTB)
#define PG8_STAGE(bufoff, gbase, voff) do { _Pragma("unroll") for (int _i = 0; _i < 2; ++_i) \
        __builtin_amdgcn_global_load_lds((const unsigned*)((const char*)(gbase) + (voff)[_i]), (PG8_LAS unsigned*)(lds + (bufoff) + ldsw + _i * 8192), 16, 0, 0); } while (0)
#define PG8_LDA(dst, b, h) do { _Pragma("unroll") for (int m = 0; m < 4; ++m) _Pragma("unroll") for (int k = 0; k < 2; ++k) dst[m][k] = *(const PG8_LAS bf16x8*)(lds + PG8_SA(b, h) + aoff + m * 2048 + k * 1024); } while (0)
#define PG8_LDB(dst, b, h) do { _Pragma("unroll") for (int n = 0; n < 2; ++n) _Pragma("unroll") for (int k = 0; k < 2; ++k) dst[n][k] = *(const PG8_LAS bf16x8*)(lds + PG8_SB(b, h) + boff + n * 2048 + k * 1024); } while (0)
#define PG8_MMA(ai, bj, At, Bt) do { __builtin_amdgcn_s_setprio(1); _Pragma("unroll") for (int m = 0; m < 4; ++m) _Pragma("unroll") for (int n = 0; n < 2; ++n) _Pragma("unroll") for (int k = 0; k < 2; ++k) \
        acc[ai][bj][m][n] = __builtin_amdgcn_mfma_f32_16x16x32_bf16(Bt[n][k], At[m][k], acc[ai][bj][m][n], 0, 0, 0); __builtin_amdgcn_s_setprio(0); } while (0)
#define PG8_WAIT_V(n) asm volatile("s_waitcnt vmcnt(" #n ")" ::: "memory")
#define PG8_WAIT_L(n) asm volatile("s_waitcnt lgkmcnt(" #n ")" ::: "memory")
#define PG8_BAR __builtin_amdgcn_s_barrier()
#define PG8_SCHED __builtin_amdgcn_sched_barrier(0)
    Unit cur, nxt; int ui = 0;
    if (!S.next(0, cur)) return;
    f32x4 acc[2][2][4][2];
#pragma unroll
    for (int a = 0; a < 2; ++a)
#pragma unroll
        for (int b = 0; b < 2; ++b)
#pragma unroll
            for (int m = 0; m < 4; ++m)
#pragma unroll
                for (int n = 0; n < 2; ++n) acc[a][b][m][n] = (f32x4){0.f, 0.f, 0.f, 0.f};
    bf16x8 At[4][2], B0[2][2], B1[2][2];
    const char* cA = (const char*)g.A + (size_t)cur.pm * tstep; const char* cB = (const char*)g.Bt + (size_t)cur.pn * tstep;
    S.a_ready(cur);
    if constexpr (SP2) {
        PG8_STAGE(PG8_SB(0, 0), cB, voffB); PG8_STAGE(PG8_SB(0, 1), cB + hstep, voffB); PG8_STAGE(PG8_SA(0, 0), cA, voffA); PG8_STAGE(PG8_SA(0, 1), cA + hstep, voffA);
        if (wr == 1) PG8_BAR;
        PG8_WAIT_V(2); PG8_BAR;
        PG8_STAGE(PG8_SB(1, 0), cB + kstep, voffB); PG8_STAGE(PG8_SA(1, 0), cA + kstep, voffA); PG8_STAGE(PG8_SB(1, 1), cB + hstep + kstep, voffB);
        PG8_WAIT_V(6); PG8_BAR;
    } else {
        PG8_STAGE(PG8_SB(0, 0), cB, voffB); PG8_STAGE(PG8_SA(0, 0), cA, voffA); PG8_STAGE(PG8_SB(0, 1), cB + hstep, voffB); PG8_STAGE(PG8_SA(0, 1), cA + hstep, voffA);
        if (wr == 1) PG8_BAR;
        PG8_WAIT_V(4); PG8_BAR;
        PG8_STAGE(PG8_SB(1, 0), cB + kstep, voffB); PG8_STAGE(PG8_SA(1, 0), cA + kstep, voffA); PG8_STAGE(PG8_SB(1, 1), cB + hstep + kstep, voffB);
        PG8_WAIT_V(6); PG8_BAR;
    }
    for (;;) {
        const bool has_next = S.next(ui + 1, nxt);
        const char* nA = has_next ? (const char*)g.A + (size_t)nxt.pm * tstep : cA; const char* nB = has_next ? (const char*)g.Bt + (size_t)nxt.pn * tstep : cB;
        for (int t = 0; t < nt; t += 2) {
            const bool last = (t == nt - 2);
            const char* a1 = cA + (size_t)(t + 1) * kstep;
            const char* a2 = last ? nA : cA + (size_t)(t + 2) * kstep; const char* b2 = last ? nB : cB + (size_t)(t + 2) * kstep;
            const char* a3 = a2 + kstep; const char* b3 = b2 + kstep;
            if (last && has_next) S.a_ready(nxt);
            if constexpr (SP2) {
            PG8_LDB(B0, 0, 0); PG8_LDB(B1, 0, 1); PG8_SCHED; PG8_LDA(At, 0, 0); PG8_STAGE(PG8_SA(1, 1), a1 + hstep, voffA);
            PG8_WAIT_V(8); PG8_WAIT_L(0); PG8_BAR; PG8_MMA(0, 0, At, B0); PG8_MMA(0, 1, At, B1); PG8_BAR; PG8_SCHED;
            PG8_LDA(At, 0, 1); PG8_STAGE(PG8_SB(0, 0), b2, voffB); PG8_STAGE(PG8_SB(0, 1), b2 + hstep, voffB); PG8_STAGE(PG8_SA(0, 0), a2, voffA);
            PG8_WAIT_V(8); PG8_WAIT_L(0); PG8_BAR; PG8_MMA(1, 0, At, B0); PG8_MMA(1, 1, At, B1); PG8_BAR; PG8_SCHED;
            PG8_LDB(B0, 1, 0); PG8_LDB(B1, 1, 1); PG8_SCHED; PG8_LDA(At, 1, 0); PG8_STAGE(PG8_SA(0, 1), a2 + hstep, voffA);
            PG8_WAIT_V(8); PG8_WAIT_L(0); PG8_BAR; PG8_MMA(0, 0, At, B0); PG8_MMA(0, 1, At, B1); PG8_BAR; PG8_SCHED;
            PG8_LDA(At, 1, 1); PG8_STAGE(PG8_SB(1, 0), b3, voffB); PG8_STAGE(PG8_SB(1, 1), b3 + hstep, voffB); PG8_STAGE(PG8_SA(1, 0), a3, voffA);
            PG8_WAIT_V(8); PG8_WAIT_L(0); PG8_BAR; PG8_MMA(1, 0, At, B0); PG8_MMA(1, 1, At, B1); PG8_BAR; PG8_SCHED;
            } else {
            PG8_LDB(B0, 0, 0); PG8_SCHED; PG8_LDA(At, 0, 0); PG8_STAGE(PG8_SA(1, 1), a1 + hstep, voffA);
            PG8_WAIT_L(8); PG8_BAR; PG8_WAIT_L(0); PG8_MMA(0, 0, At, B0); PG8_BAR; PG8_SCHED;
            PG8_LDB(B1, 0, 1); PG8_STAGE(PG8_SB(0, 0), b2, voffB);
            PG8_BAR; PG8_WAIT_L(0); PG8_MMA(0, 1, At, B1); PG8_BAR;
            PG8_LDA(At, 0, 1); PG8_STAGE(PG8_SA(0, 0), a2, voffA);
            PG8_BAR; PG8_WAIT_L(0); PG8_MMA(1, 0, At, B0); PG8_BAR; PG8_SCHED;
            PG8_STAGE(PG8_SB(0, 1), b2 + hstep, voffB);
            PG8_WAIT_V(6); PG8_BAR; PG8_MMA(1, 1, At, B1); PG8_BAR;
            PG8_LDB(B0, 1, 0); PG8_SCHED; PG8_LDA(At, 1, 0); PG8_STAGE(PG8_SA(0, 1), a2 + hstep, voffA);
            PG8_WAIT_L(8); PG8_BAR; PG8_WAIT_L(0); PG8_MMA(0, 0, At, B0); PG8_BAR; PG8_SCHED;
            PG8_LDB(B1, 1, 1); PG8_STAGE(PG8_SB(1, 0), b3, voffB);
            PG8_BAR; PG8_WAIT_L(0); PG8_MMA(0, 1, At, B1); PG8_BAR;
            PG8_LDA(At, 1, 1); PG8_STAGE(PG8_SA(1, 0), a3, voffA);
            PG8_BAR; PG8_WAIT_L(0); PG8_MMA(1, 0, At, B0); PG8_BAR; PG8_SCHED;
            PG8_STAGE(PG8_SB(1, 1), b3 + hstep, voffB);
            PG8_WAIT_V(6); PG8_BAR; PG8_MMA(1, 1, At, B1); PG8_BAR;
            }
        }
        if constexpr (ALIGN_EPI) { if (wr == 0) PG8_BAR; }
        if constexpr (!Epi::AFTER_DRAIN) { E(acc, cur, wr, wc, fr, fq); S.done(cur); }
        if (!has_next) break;
#pragma unroll
        for (int a = 0; a < 2; ++a)
#pragma unroll
            for (int b = 0; b < 2; ++b)
#pragma unroll
                for (int m = 0; m < 4; ++m)
#pragma unroll
                    for (int n = 0; n < 2; ++n) acc[a][b][m][n] = (f32x4){0.f, 0.f, 0.f, 0.f};
        cur = nxt; cA = nA; cB = nB; ++ui;
        if constexpr (ALIGN_EPI) { if (wr == 1) PG8_BAR; }
    }
    PG8_WAIT_V(0);
    if constexpr (!ALIGN_EPI) { if (wr == 0) PG8_BAR; }
    PG8_BAR;
    if constexpr (Epi::AFTER_DRAIN) { E.fused(acc, cur, wr, wc, fr, fq, lds, wid, lane); S.done(cur); }
#undef PG8_SA
#undef PG8_SB
#undef PG8_STAGE
#undef PG8_LDA
#undef PG8_LDB
#undef PG8_MMA
#undef PG8_WAIT_V
#undef PG8_WAIT_L
#undef PG8_BAR
#undef PG8_SCHED
}
}

typedef pg8::bf16_t bf16_t;
typedef pg8::f32x4 f32x4;
typedef pg8::u32x4 u32x4;
typedef unsigned u32x2 __attribute__((ext_vector_type(2)));

constexpr int M = 32768, D = 1024, NPROJ = 2560, DFF = 2816, NUP = 5632;
constexpr float EPS = 1e-6f;
constexpr size_t MBY = 1048576;
constexpr size_t WS_WIN = 0, WS_WOUT = 5 * MBY, WS_WUP = 7 * MBY, WS_WDOWN = 18 * MBY, WS_BETA = 24 * MBY, WS_G = 24 * MBY + MBY / 2, WS_SS2 = 25 * MBY;
constexpr size_t WS_H1B = 32 * MBY, WS_MIX = 32 * MBY, WS_PROJ = 96 * MBY, WS_QB = 256 * MBY, WS_KB = 288 * MBY, WS_VB = 320 * MBY, WS_OF = 352 * MBY;
constexpr size_t WS_XB = 96 * MBY, WS_UPH = 160 * MBY, WS_ACT = 336 * MBY, WS_END = 512 * MBY;
constexpr size_t WS_KT = 32 * MBY, WS_VT = 64 * MBY, WS_RS1 = 27 * MBY + 262144;
constexpr int LDS_BYTES = 131072 + 256 + 8192, NT = 512;
constexpr size_t WS_BAR = 30 * MBY;

struct Args { const float* in[17]; float* out; unsigned char* ws; unsigned mask; unsigned pad; };

__device__ __forceinline__ float bf_lo(unsigned w) { return __uint_as_float(w << 16); }
__device__ __forceinline__ float bf_hi(unsigned w) { return __uint_as_float(w & 0xffff0000u); }
typedef float f32x2_ __attribute__((ext_vector_type(2)));
typedef __bf16 bf16x2_ __attribute__((ext_vector_type(2)));
__device__ __forceinline__ unsigned pk2(float a, float b) { return pg8::cvt_pk_bf16(a, b); }
__device__ __forceinline__ unsigned pk2c(float a, float b) { const f32x2_ v = {a, b}; const bf16x2_ r = __builtin_convertvector(v, bf16x2_); return __builtin_bit_cast(unsigned, r); }
__device__ __forceinline__ void unpack8(const u32x4 w, float (&f)[8]) { f[0] = bf_lo(w.x); f[1] = bf_hi(w.x); f[2] = bf_lo(w.y); f[3] = bf_hi(w.y); f[4] = bf_lo(w.z); f[5] = bf_hi(w.z); f[6] = bf_lo(w.w); f[7] = bf_hi(w.w); }
__device__ __forceinline__ u32x4 pack8(const float (&f)[8]) { u32x4 o; o.x = pk2(f[0], f[1]); o.y = pk2(f[2], f[3]); o.z = pk2(f[4], f[5]); o.w = pk2(f[6], f[7]); return o; }
__device__ __forceinline__ float wave_sum(float v) {
#pragma unroll
    for (int o = 1; o < 64; o <<= 1) v += __shfl_xor(v, o);
    return v;
}
template <int CTRL> __device__ __forceinline__ float dpp_mov(float x) { return __builtin_bit_cast(float, __builtin_amdgcn_update_dpp(0, __builtin_bit_cast(int, x), CTRL, 0xf, 0xf, true)); }
__device__ __forceinline__ float sum16(float v) {
    v += dpp_mov<0x128>(v); v += dpp_mov<0x124>(v); v += dpp_mov<0x122>(v); v += dpp_mov<0x121>(v);
    return v;
}
__device__ __forceinline__ float row_up1(float v) { return dpp_mov<0x111>(v); }
__device__ __forceinline__ float sigmoidf_(float x) { return __builtin_amdgcn_rcpf(1.0f + __builtin_amdgcn_exp2f(x * -1.4426950408889634f)); }
__device__ __forceinline__ float siluf_(float x) { return x * __builtin_amdgcn_rcpf(1.0f + __builtin_amdgcn_exp2f(x * -1.4426950408889634f)); }

struct EpiBf16Plain {
    static constexpr bool PERM = true, PERMA = false, AFTER_DRAIN = false;
    bf16_t* O; int ldc; const float* RS;
    __device__ __forceinline__ void operator()(const f32x4 (&acc)[2][2][4][2], const pg8::Unit& u, int wr, int wc, int fr, int fq) const {
        const int row0 = u.pm * 256 + wr * 64 + fr, col0 = u.pn * 256 + wc * 32 + 8 * fq;
        float rs[2][4];
#pragma unroll
        for (int ai = 0; ai < 2; ++ai)
#pragma unroll
            for (int m = 0; m < 4; ++m) rs[ai][m] = RS[row0 + ai * 128 + m * 16];
#pragma unroll
        for (int ai = 0; ai < 2; ++ai)
#pragma unroll
            for (int m = 0; m < 4; ++m) { bf16_t* rowp = O + (size_t)(row0 + ai * 128 + m * 16) * ldc + col0;
#pragma unroll
                for (int bj = 0; bj < 2; ++bj) { const f32x4 v0 = acc[ai][bj][m][0] * rs[ai][m], v1 = acc[ai][bj][m][1] * rs[ai][m];
                    u32x4 w; w.x = pk2(v0[0], v0[1]); w.y = pk2(v0[2], v0[3]); w.z = pk2(v1[0], v1[1]); w.w = pk2(v1[2], v1[3]);
                    *(u32x4*)(rowp + bj * 128) = w; } }
    }
};
struct EpiOutProj {
    static constexpr bool PERM = true, PERMA = false, AFTER_DRAIN = false;
    const bf16_t* X; bf16_t* XB; float* SS;
    __device__ __forceinline__ void operator()(f32x4 (&acc)[2][2][4][2], const pg8::Unit& u, int wr, int wc, int fr, int fq) const {
        const int row0 = u.pm * 256 + wr * 64 + fr, col0 = u.pn * 256 + wc * 32 + 8 * fq;
#pragma unroll
        for (int ai = 0; ai < 2; ++ai) {
            f32x4 rx[4][2][2];
#pragma unroll
            for (int m = 0; m < 4; ++m)
#pragma unroll
                for (int bj = 0; bj < 2; ++bj) { float f[8]; unpack8(*(const u32x4*)(X + (size_t)(row0 + ai * 128 + m * 16) * 1024 + col0 + bj * 128), f);
                    rx[m][bj][0] = (f32x4){f[0], f[1], f[2], f[3]}; rx[m][bj][1] = (f32x4){f[4], f[5], f[6], f[7]}; }
#pragma unroll
            for (int m = 0; m < 4; ++m) { const int row = row0 + ai * 128 + m * 16; float s = 0.f;
#pragma unroll
                for (int bj = 0; bj < 2; ++bj) { const f32x4 v0 = acc[ai][bj][m][0] + rx[m][bj][0], v1 = acc[ai][bj][m][1] + rx[m][bj][1];
                    s += (v0[0] * v0[0] + v0[1] * v0[1]) + (v0[2] * v0[2] + v0[3] * v0[3]) + (v1[0] * v1[0] + v1[1] * v1[1]) + (v1[2] * v1[2] + v1[3] * v1[3]);
                    u32x4 w; w.x = pk2(v0[0], v0[1]); w.y = pk2(v0[2], v0[3]); w.z = pk2(v1[0], v1[1]); w.w = pk2(v1[2], v1[3]);
                    *(u32x4*)(XB + (size_t)row * 1024 + col0 + bj * 128) = w; }
                s += __shfl_xor(s, 16); s += __shfl_xor(s, 32); if (fq == 0) SS[(size_t)row * 16 + u.pn * 4 + wc] = s; }
        }
    }
};
constexpr size_t WS_YB = 192 * MBY, WS_SS3 = 25 * MBY;
struct EpiDown {
    static constexpr bool PERM = true, PERMA = false, AFTER_DRAIN = false;
    const bf16_t* XB; bf16_t* YB; float* SS;
    __device__ __forceinline__ void operator()(f32x4 (&acc)[2][2][4][2], const pg8::Unit& u, int wr, int wc, int fr, int fq) const {
        const int row0 = u.pm * 256 + wr * 64 + fr, col0 = u.pn * 256 + wc * 32 + 8 * fq;
#pragma unroll
        for (int ai = 0; ai < 2; ++ai) {
            u32x4 rx[4][2];
#pragma unroll
            for (int m = 0; m < 4; ++m)
#pragma unroll
                for (int bj = 0; bj < 2; ++bj) rx[m][bj] = *(const u32x4*)(XB + (size_t)(row0 + ai * 128 + m * 16) * 1024 + col0 + bj * 128);
#pragma unroll
            for (int m = 0; m < 4; ++m) { const int row = row0 + ai * 128 + m * 16; float s = 0.f;
#pragma unroll
                for (int bj = 0; bj < 2; ++bj) { float f[8]; unpack8(rx[m][bj], f);
                    const f32x4 v0 = acc[ai][bj][m][0] + (f32x4){f[0], f[1], f[2], f[3]}, v1 = acc[ai][bj][m][1] + (f32x4){f[4], f[5], f[6], f[7]};
                    s += (v0[0] * v0[0] + v0[1] * v0[1]) + (v0[2] * v0[2] + v0[3] * v0[3]) + (v1[0] * v1[0] + v1[1] * v1[1]) + (v1[2] * v1[2] + v1[3] * v1[3]);
                    u32x4 w; w.x = pk2(v0[0], v0[1]); w.y = pk2(v0[2], v0[3]); w.z = pk2(v1[0], v1[1]); w.w = pk2(v1[2], v1[3]);
                    *(u32x4*)(YB + (size_t)row * 1024 + col0 + bj * 128) = w; }
                s += __shfl_xor(s, 16); s += __shfl_xor(s, 32); if (fq == 0) SS[(size_t)row * 16 + u.pn * 4 + wc] = s; }
        }
    }
};
struct EpiUpRaw {
    static constexpr bool PERM = true, PERMA = false, AFTER_DRAIN = false;
    bf16_t* O; const float* SS;
    __device__ __forceinline__ void operator()(const f32x4 (&acc)[2][2][4][2], const pg8::Unit& u, int wr, int wc, int fr, int fq) const {
        const int row0 = u.pm * 256 + wr * 64 + fr, col0 = u.pn * 256 + wc * 32 + 8 * fq;
#pragma unroll
        for (int ai = 0; ai < 2; ++ai)
#pragma unroll
            for (int m = 0; m < 4; ++m) { const int row = row0 + ai * 128 + m * 16;
                const f32x4 sv = *(const f32x4*)(SS + (size_t)row * 16 + 4 * fq); float s = (sv[0] + sv[1]) + (sv[2] + sv[3]); s += __shfl_xor(s, 16); s += __shfl_xor(s, 32);
                const float rstd = rsqrtf(s * (1.0f / 1024.0f) + EPS);
                bf16_t* rowp = O + (size_t)row * NUP + col0;
#pragma unroll
                for (int bj = 0; bj < 2; ++bj) { const f32x4 v0 = acc[ai][bj][m][0] * rstd, v1 = acc[ai][bj][m][1] * rstd;
                    u32x4 w; w.x = pk2(v0[0], v0[1]); w.y = pk2(v0[2], v0[3]); w.z = pk2(v1[0], v1[1]); w.w = pk2(v1[2], v1[3]);
                    *(u32x4*)(rowp + bj * 128) = w; } }
    }
};

constexpr size_t WS_HALO = 160 * MBY, WS_PWT = 28 * MBY;
struct EpiUpFused {
    static constexpr bool PERM = true, PERMA = true, AFTER_DRAIN = false;
    bf16_t* ACT; bf16_t* HALO; const float* SS; const float* FW; const float* FB; PG8_LAS unsigned char* WL;
    __device__ __forceinline__ void operator()(f32x4 (&acc)[2][2][4][2], const pg8::Unit& u, int wr, int wc, int fr, int fq) const {
        const int colj = u.pn * 128 + wc * 32 + 8 * fq;
        PG8_LAS unsigned char* wl = WL + (wr * 4 + wc) * 1024;
        {
            const int l = fq * 16 + fr, p = l >> 4, bj = (l >> 3) & 1, c4 = (l & 7) * 4;
            const float* srcp = (p < 3 ? FW + p * NUP : FB) + bj * DFF + u.pn * 128 + wc * 32 + c4;
            *(PG8_LAS f32x4*)(wl + l * 16) = *(const f32x4*)srcp;
        }
#pragma unroll
        for (int ai = 0; ai < 2; ++ai) {
            const int tb = u.pm * 256 + ai * 128 + wr * 64 + 4 * fr;
            float rstd[4];
#pragma unroll
            for (int m = 0; m < 4; ++m) { const f32x4 sv = *(const f32x4*)(SS + (size_t)(tb + m) * 16 + 4 * fq); float s = (sv[0] + sv[1]) + (sv[2] + sv[3]); s += __shfl_xor(s, 16); s += __shfl_xor(s, 32);
                rstd[m] = rsqrtf(s * (1.0f / 1024.0f) + EPS); }
            u32x2 pk[2][4];
#pragma unroll
            for (int n = 0; n < 2; ++n) {
                f32x4 g[4];
                {   const PG8_LAS unsigned char* wq = wl + (8 * fq + 4 * n) * 4;
                    const f32x4 w0 = *(const PG8_LAS f32x4*)(wq), w1 = *(const PG8_LAS f32x4*)(wq + 256), w2 = *(const PG8_LAS f32x4*)(wq + 512), bb = *(const PG8_LAS f32x4*)(wq + 768);
                    const f32x4 x0 = acc[ai][0][0][n] * rstd[0], x1 = acc[ai][0][1][n] * rstd[1], x2 = acc[ai][0][2][n] * rstd[2], x3 = acc[ai][0][3][n] * rstd[3];
                    acc[ai][0][0][n] = x0; acc[ai][0][1][n] = x1; acc[ai][0][2][n] = x2; acc[ai][0][3][n] = x3;
                    f32x4 p1, p2;
#pragma unroll
                    for (int c = 0; c < 4; ++c) { p1[c] = row_up1(x3[c]); p2[c] = row_up1(x2[c]); }
                    g[0] = bb + w2 * x0 + w1 * p1 + w0 * p2; g[1] = bb + w2 * x1 + w1 * x0 + w0 * p1;
                    g[2] = bb + w2 * x2 + w1 * x1 + w0 * x0; g[3] = bb + w2 * x3 + w1 * x2 + w0 * x1;
#pragma unroll
                    for (int m = 0; m < 4; ++m)
#pragma unroll
                        for (int c = 0; c < 4; ++c) g[m][c] = siluf_(g[m][c]);
                }
                __builtin_amdgcn_sched_barrier(0);
                {   const PG8_LAS unsigned char* wq = wl + 128 + (8 * fq + 4 * n) * 4;
                    const f32x4 w0 = *(const PG8_LAS f32x4*)(wq), w1 = *(const PG8_LAS f32x4*)(wq + 256), w2 = *(const PG8_LAS f32x4*)(wq + 512), bb = *(const PG8_LAS f32x4*)(wq + 768);
                    const f32x4 x0 = acc[ai][1][0][n] * rstd[0], x1 = acc[ai][1][1][n] * rstd[1], x2 = acc[ai][1][2][n] * rstd[2], x3 = acc[ai][1][3][n] * rstd[3];
                    acc[ai][1][0][n] = x0; acc[ai][1][1][n] = x1; acc[ai][1][2][n] = x2; acc[ai][1][3][n] = x3;
                    f32x4 p1, p2;
#pragma unroll
                    for (int c = 0; c < 4; ++c) { p1[c] = row_up1(x3[c]); p2[c] = row_up1(x2[c]); }
                    g[0] *= bb + w2 * x0 + w1 * p1 + w0 * p2; g[1] *= bb + w2 * x1 + w1 * x0 + w0 * p1;
                    g[2] *= bb + w2 * x2 + w1 * x1 + w0 * x0; g[3] *= bb + w2 * x3 + w1 * x2 + w0 * x1;
                }
#pragma unroll
                for (int m = 0; m < 4; ++m) { pk[n][m].x = pk2(g[m][0], g[m][1]); pk[n][m].y = pk2(g[m][2], g[m][3]); }
                __builtin_amdgcn_sched_barrier(0);
            }
#pragma unroll
            for (int m = 0; m < 4; ++m) if (fr != 0 || m >= 2) {
                u32x4 w; w.x = pk[0][m].x; w.y = pk[0][m].y; w.z = pk[1][m].x; w.w = pk[1][m].y;
                *(u32x4*)(ACT + (size_t)(tb + m) * DFF + colj) = w; }
            const int seg = u.pm * 4 + ai * 2 + wr;
            if (fr == 0 || fr == 15) {
#pragma unroll
                for (int mm = 0; mm < 2; ++mm) { const int m = (fr == 0) ? mm : 2 + mm;
#pragma unroll
                    for (int bj = 0; bj < 2; ++bj) { const f32x4 v0 = (fr == 0) ? acc[ai][bj][mm][0] : acc[ai][bj][2 + mm][0], v1 = (fr == 0) ? acc[ai][bj][mm][1] : acc[ai][bj][2 + mm][1];
                        u32x4 w; w.x = pk2(v0[0], v0[1]); w.y = pk2(v0[2], v0[3]); w.z = pk2(v1[0], v1[1]); w.w = pk2(v1[2], v1[3]);
                        *(u32x4*)(HALO + ((size_t)(seg * 4 + m) * 2 + bj) * DFF + colj) = w; } }
            }
        }
    }
};
__device__ __forceinline__ void phase_fixup(const Args& a) {
    const bf16_t* halo = (const bf16_t*)(a.ws + WS_HALO); bf16_t* act = (bf16_t*)(a.ws + WS_ACT);
    const float* fw = a.in[13]; const float* fb = a.in[14];
    const int total = 512 * 2 * 352;
    for (int it = blockIdx.x * NT + threadIdx.x; it < total; it += gridDim.x * NT) {
        const int p = it % 352, rs = it / 352, rho = rs & 1, seg = rs >> 1, j0 = p * 8; const bool first = (seg & 31) == 0; const size_t t = (size_t)seg * 64 + rho;
        float o[2][8];
#pragma unroll
        for (int bj = 0; bj < 2; ++bj) { const int col = bj * DFF + j0;
            float cur[8], m1[8], m2[8];
            unpack8(*(const u32x4*)(halo + ((size_t)(seg * 4 + rho) * 2 + bj) * DFF + j0), cur);
#pragma unroll
            for (int e = 0; e < 8; ++e) { m1[e] = 0.f; m2[e] = 0.f; }
            if (rho == 1) { unpack8(*(const u32x4*)(halo + ((size_t)(seg * 4 + 0) * 2 + bj) * DFF + j0), m1);
                if (!first) unpack8(*(const u32x4*)(halo + ((size_t)((seg - 1) * 4 + 3) * 2 + bj) * DFF + j0), m2); }
            else if (!first) { unpack8(*(const u32x4*)(halo + ((size_t)((seg - 1) * 4 + 3) * 2 + bj) * DFF + j0), m1);
                unpack8(*(const u32x4*)(halo + ((size_t)((seg - 1) * 4 + 2) * 2 + bj) * DFF + j0), m2); }
#pragma unroll
            for (int e = 0; e < 8; ++e) o[bj][e] = fb[col + e] + fw[2 * NUP + col + e] * cur[e] + fw[NUP + col + e] * m1[e] + fw[col + e] * m2[e];
        }
        float r8[8];
#pragma unroll
        for (int e = 0; e < 8; ++e) r8[e] = siluf_(o[0][e]) * o[1][e];
        *(u32x4*)(act + t * DFF + j0) = pack8(r8);
    }
}
#define GAS __attribute__((address_space(1)))
struct TileDesc { const float* W; bf16_t* WT; const float* ks; int ldw, K, k0, n0, src; };
constexpr int TW_IN = 8 * 40, TW_OUT = 8 * 16, TW_UP = 8 * 88, TW_DN = 22 * 16, TW_PW = 4 * 2;
constexpr int TW_A = TW_IN, TW_B = TW_A + TW_PW, TW_END = TW_B + TW_OUT + TW_UP + TW_DN;
__device__ __forceinline__ TileDesc tile_desc(const Args& a, int it) {
    TileDesc t; int r = it; t.ks = nullptr;
    if (r < TW_IN) { const int kb = r / 40, nb = r % 40, n0 = nb * 64; t.W = a.in[2]; t.ldw = 2568; t.WT = (bf16_t*)(a.ws + WS_WIN); t.K = 1024; t.k0 = kb * 128; t.n0 = n0; t.src = n0 < 2048 ? n0 : n0 + 8; t.ks = a.in[1]; return t; }
    r -= TW_IN;
    if (r < TW_PW) { const int kb = r / 2, nb = r % 2; t.W = a.in[7]; t.ldw = 128; t.WT = (bf16_t*)(a.ws + WS_PWT); t.K = 512; t.k0 = kb * 128; t.n0 = nb * 64; t.src = nb * 64; return t; }
    r -= TW_PW;
    if (r < TW_OUT) { const int kb = r / 16, nb = r % 16; t.W = a.in[10]; t.ldw = 1024; t.WT = (bf16_t*)(a.ws + WS_WOUT); t.K = 1024; t.k0 = kb * 128; t.n0 = nb * 64; t.src = nb * 64; return t; }
    r -= TW_OUT;
    if (r < TW_UP) { const int kb = r / 88, nb = r % 88, n0 = nb * 64, pn = n0 >> 8, rr = n0 & 255; t.W = a.in[12]; t.ldw = NUP; t.WT = (bf16_t*)(a.ws + WS_WUP); t.K = 1024; t.k0 = kb * 128; t.n0 = n0;
        t.src = (rr >> 7) * DFF + pn * 128 + (rr & 127); t.ks = a.in[11]; return t; }
    r -= TW_UP;
    { const int kb = r / 16, nb = r % 16; t.W = a.in[15]; t.ldw = 1024; t.WT = (bf16_t*)(a.ws + WS_WDOWN); t.K = DFF; t.k0 = kb * 128; t.n0 = nb * 64; t.src = nb * 64; return t; }
}
__device__ __forceinline__ void tile_load(const TileDesc& t, float (&v)[16]) {
    const int tid = threadIdx.x;
#pragma unroll
    for (int i = 0; i < 16; ++i) { const int kk = i * 8 + (tid >> 6), j = tid & 63; v[i] = t.W[(size_t)(t.k0 + kk) * t.ldw + t.src + j]; }
    if (t.ks) { float sc[16];
#pragma unroll
        for (int i = 0; i < 16; ++i) sc[i] = t.ks[t.k0 + i * 8 + (tid >> 6)];
#pragma unroll
        for (int i = 0; i < 16; ++i) v[i] *= sc[i]; }
}
__device__ __forceinline__ void phase_weights(const Args& a, PG8_LAS float* tile, int lo, int NTILES, int bid, int nb) {
    const int tid = threadIdx.x;
    int it = lo + bid; if (it >= NTILES) return;
    TileDesc cur = tile_desc(a, it); float v[16]; tile_load(cur, v);
    for (;;) {
#pragma unroll
        for (int i = 0; i < 16; ++i) tile[(i * 8 + (tid >> 6)) * 65 + (tid & 63)] = v[i];
        __syncthreads();
        const int nit = it + nb; const bool more = nit < NTILES; TileDesc nx = cur;
        if (more) { nx = tile_desc(a, nit); tile_load(nx, v); }
#pragma unroll
        for (int hh = 0; hh < 2; ++hh) { const int pidx = tid + 512 * hh, j = pidx >> 4, c = pidx & 15; const PG8_LAS float* s = tile + (8 * c) * 65 + j;
          u32x4 o; o.x = pk2(s[0], s[65]); o.y = pk2(s[130], s[195]); o.z = pk2(s[260], s[325]); o.w = pk2(s[390], s[455]);
          *(u32x4*)(cur.WT + (size_t)(cur.n0 + j) * cur.K + cur.k0 + 8 * c) = o; }
        __syncthreads();
        if (!more) break;
        cur = nx; it = nit;
    }
}
__device__ __forceinline__ void phase_norm1(const Args& a, float* wba) {
    const int tid = threadIdx.x, lane = tid & 63, wave = tid >> 6;
    const float* x = a.in[0]; const float* nw1 = a.in[1]; const float* w_in = a.in[2];
    bf16_t* h1b = (bf16_t*)a.out; float* rs1 = (float*)(a.ws + WS_RS1); float* betaB = (float*)(a.ws + WS_BETA); float* gB = (float*)(a.ws + WS_G);
    for (int k = tid; k < 1024; k += NT) { const float nw = nw1[k];
#pragma unroll
        for (int c = 0; c < 8; ++c) wba[c * 1024 + k] = w_in[(size_t)k * 2568 + 2048 + c] * nw; }
    __syncthreads();
    const int hh = (lane >> 3) & 3; const float alog = a.in[4][hh], dtb = a.in[5][hh]; const float aexp = -__expf(alog);
    f32x4 nwv[4];
#pragma unroll
    for (int j = 0; j < 4; ++j) nwv[j] = *(const f32x4*)(nw1 + 256 * j + 4 * lane);
    for (int row = blockIdx.x * 8 + wave; row < M; row += gridDim.x * 8) {
        const f32x4* xr = (const f32x4*)(x + (size_t)row * 1024) + lane;
        f32x4 v[4]; float ss = 0.f;
#pragma unroll
        for (int j = 0; j < 4; ++j) { v[j] = xr[64 * j]; ss += (v[j][0] * v[j][0] + v[j][1] * v[j][1]) + (v[j][2] * v[j][2] + v[j][3] * v[j][3]); }
        ss = wave_sum(ss); const float rstd = rsqrtf(ss * (1.0f / 1024.0f) + EPS);
        float d[8];
#pragma unroll
        for (int c = 0; c < 8; ++c) { float s = 0.f;
#pragma unroll
            for (int j = 0; j < 4; ++j) { const f32x4 w = *(const f32x4*)(wba + c * 1024 + 256 * j + 4 * lane); s += (v[j][0] * w[0] + v[j][1] * w[1]) + (v[j][2] * w[2] + v[j][3] * w[3]); }
            d[c] = s; }
        float dsum;
        { const bool b5 = lane & 32, b4 = lane & 16, b3 = lane & 8; float r4[4], r2[2];
#pragma unroll
          for (int i = 0; i < 4; ++i) { const float snd = b5 ? d[i] : d[4 + i], kp = b5 ? d[4 + i] : d[i]; r4[i] = kp + __shfl_xor(snd, 32); }
#pragma unroll
          for (int i = 0; i < 2; ++i) { const float snd = b4 ? r4[i] : r4[2 + i], kp = b4 ? r4[2 + i] : r4[i]; r2[i] = kp + __shfl_xor(snd, 16); }
          { const float snd = b3 ? r2[0] : r2[1], kp = b3 ? r2[1] : r2[0]; dsum = kp + __shfl_xor(snd, 8); }
          dsum += __shfl_xor(dsum, 4); dsum += __shfl_xor(dsum, 2); dsum += __shfl_xor(dsum, 1); dsum *= rstd; }
        bf16_t* hr = h1b + (size_t)row * 1024 + 4 * lane;
#pragma unroll
        for (int j = 0; j < 4; ++j) { const f32x4 h = v[j]; u32x2 w; w.x = pk2(h[0], h[1]); w.y = pk2(h[2], h[3]); *(u32x2*)(hr + 256 * j) = w; }
        if (lane == 0) rs1[row] = rstd;
        if ((lane & 7) == 0) { const int c = lane >> 3;
            if (c < 4) betaB[(size_t)row * 4 + c] = sigmoidf_(dsum);
            else { const float z = dsum + dtb; const float sp = z > 20.f ? z : log1pf(__expf(z)); gB[(size_t)row * 4 + (c - 4)] = aexp * sp; } }
    }
}

__device__ __forceinline__ void phase_qkv(const Args& a) {
    const int tid = threadIdx.x, lane = tid & 63, wave = tid >> 6;
    const bf16_t* proj = (const bf16_t*)(a.ws + WS_PROJ); const float* cw = a.in[3];
    for (int item = blockIdx.x * 8 + wave; item < 6144; item += gridDim.x * 8) {
        const int part = item % 3, rg = item / 3, rowA = rg * 16, pos0 = rowA & 2047, ch0 = part * 512 + 8 * lane;
        float w[4][8];
#pragma unroll
        for (int i = 0; i < 4; ++i) { const f32x4 w0 = *(const f32x4*)(cw + i * 1536 + ch0), w1 = *(const f32x4*)(cw + i * 1536 + ch0 + 4);
            w[i][0] = w0[0]; w[i][1] = w0[1]; w[i][2] = w0[2]; w[i][3] = w0[3]; w[i][4] = w1[0]; w[i][5] = w1[1]; w[i][6] = w1[2]; w[i][7] = w1[3]; }
        u32x4 R[19];
#pragma unroll
        for (int j = 0; j < 19; ++j) { const int dr = j - 3; const int rr = (pos0 + dr >= 0) ? rowA + dr : rowA; R[j] = *(const u32x4*)(proj + (size_t)rr * NPROJ + ch0); }
        bf16_t* dst = (bf16_t*)(a.ws + (part == 0 ? WS_QB : WS_KB)) + (size_t)rowA * 512 + 8 * lane;
        const float qsc = (part == 0) ? 0.08838834764831845f : 1.0f;
        u32x4 yb[16]; float F[19][8];
#pragma unroll
        for (int m = 0; m < 16; ++m) {
            float acc[8];
#pragma unroll
            for (int e = 0; e < 8; ++e) acc[e] = 0.f;
            if (m == 0) { unpack8(R[0], F[0]); unpack8(R[1], F[1]); unpack8(R[2], F[2]); }
            unpack8(R[m + 3], F[m + 3]);
#pragma unroll
            for (int i = 0; i < 4; ++i) {
                if (m + i < 3) { const float vm = (pos0 + m + i - 3 >= 0) ? 1.0f : 0.0f;
#pragma unroll
                    for (int e = 0; e < 8; ++e) acc[e] += F[m + i][e] * (w[i][e] * vm); }
                else {
#pragma unroll
                    for (int e = 0; e < 8; ++e) acc[e] += F[m + i][e] * w[i][e]; } }
            float ssq = 0.f;
#pragma unroll
            for (int e = 0; e < 8; ++e) { acc[e] = siluf_(acc[e]); ssq += acc[e] * acc[e]; }
            if (part < 2) { ssq = sum16(ssq); const float sc = rsqrtf(ssq + EPS) * qsc;
#pragma unroll
                for (int e = 0; e < 8; ++e) acc[e] *= sc; }
            yb[m] = pack8(acc);
            if (part < 2) *(u32x4*)(dst + (size_t)m * 512) = yb[m];
        }
        if (part > 0) {
            bf16_t* tb = (bf16_t*)(a.ws + (part == 1 ? WS_KT : WS_VT)) + ((size_t)(rg >> 2) * 512 + 8 * lane) * 64 + (rg & 3) * 16;
#pragma unroll
            for (int e = 0; e < 8; ++e) { u32x4 o0, o1;
#pragma unroll
                for (int pp = 0; pp < 8; ++pp) { const unsigned A = yb[2 * pp][e >> 1], B = yb[2 * pp + 1][e >> 1];
                    const unsigned v = (e & 1) ? ((A >> 16) | (B & 0xffff0000u)) : ((A & 0xffffu) | (B << 16));
                    if (pp < 4) o0[pp] = v; else o1[pp - 4] = v; }
                *(u32x4*)(tb + e * 64) = o0; *(u32x4*)(tb + e * 64 + 8) = o1; }
        }
    }
}
typedef pg8::bf16x8 bf16x8;
#define MFMA16(a, b, c) __builtin_amdgcn_mfma_f32_16x16x32_bf16((a), (b), (c), 0, 0, 0)
constexpr size_t WS_GL = 27 * MBY, WS_PREP = 352 * MBY, WS_OF2 = 256 * MBY;
constexpr int PREP_ITEM = 73728, PI_W = 0, PI_QG = 16384, PI_KD = 32768, PI_UT = 49152, PI_AQ = 65536;
__host__ __device__ __forceinline__ constexpr int perm32s(int o) { return 8 * ((o >> 2) & 3) + 4 * (o >> 4) + (o & 3); }
__host__ __device__ __forceinline__ constexpr int tokofpos(int p) { return (p & 32) + 16 * ((p & 7) >> 2) + 4 * ((p >> 3) & 3) + (p & 3); }
__device__ __forceinline__ bf16x8 packf8(const f32x4 lo, const f32x4 hi) { u32x4 p; p.x = pk2(lo[0], lo[1]); p.y = pk2(lo[2], lo[3]); p.z = pk2(hi[0], hi[1]); p.w = pk2(hi[2], hi[3]); return __builtin_bit_cast(bf16x8, p); }
__device__ __forceinline__ bf16_t f2bf(float x) { return (bf16_t)(pk2(x, x) & 0xffffu); }
__device__ __forceinline__ float bf2f(bf16_t x) { return __uint_as_float(((unsigned)x) << 16); }

__device__ __forceinline__ void solve64(float (&x)[64], const PG8_LAS float* sLt) {
    f32x4 cur[16];
#pragma unroll
    for (int i4 = 0; i4 < 16; ++i4) cur[i4] = *(const PG8_LAS f32x4*)(sLt + 4 * i4);
    asm volatile("" ::: "memory");
#pragma unroll
    for (int j = 0; j < 63; ++j) {
        const float xj = x[j];
#pragma unroll
        for (int i4 = (j + 1) / 4; i4 < 16; ++i4) {
            if (4 * i4 + 0 > j) x[4 * i4 + 0] -= cur[i4][0] * xj;
            if (4 * i4 + 1 > j) x[4 * i4 + 1] -= cur[i4][1] * xj;
            if (4 * i4 + 2 > j) x[4 * i4 + 2] -= cur[i4][2] * xj;
            if (4 * i4 + 3 > j) x[4 * i4 + 3] -= cur[i4][3] * xj;
            if (j + 1 < 63 && i4 >= (j + 2) / 4) cur[i4] = *(const PG8_LAS f32x4*)(sLt + (j + 1) * 64 + 4 * i4); }
        asm volatile("" ::: "memory");
    }
}

__device__ __forceinline__ void phase_prep(const Args& a, PG8_LAS unsigned char* lds) {
    const int tid = threadIdx.x, lane = tid & 63, wave = __builtin_amdgcn_readfirstlane(tid >> 6), half = wave >> 2, lw = wave & 3, q = lane >> 4, r = lane & 15;
    const int role = (lw - half) & 3;
    PG8_LAS unsigned char* hb = lds + half * 36864;
    PG8_LAS float* sG = (PG8_LAS float*)hb; PG8_LAS float* sB = sG + 64; PG8_LAS float* sE = sG + 128; PG8_LAS float* sK = sG + 192; PG8_LAS float* sL = sG + 256;
    PG8_LAS unsigned char* Tu = hb + 17408; PG8_LAS unsigned char* Tw = Tu + 9216;
    const bf16_t* qb = (const bf16_t*)(a.ws + WS_QB); const bf16_t* kb = (const bf16_t*)(a.ws + WS_KB);
    const bf16_t* kT = (const bf16_t*)(a.ws + WS_KT); const bf16_t* vT = (const bf16_t*)(a.ws + WS_VT);
    const float* betaB = (const float*)(a.ws + WS_BETA); const float* gB = (const float*)(a.ws + WS_G); float* glast = (float*)(a.ws + WS_GL);
    for (int unit = blockIdx.x; unit < 1024; unit += gridDim.x) {
        const int hp = unit & 1, bn = unit >> 1, h = 2 * hp + half, item = bn * 4 + h; const size_t r0 = (size_t)bn * 64;
        unsigned char* pi = a.ws + WS_PREP + (size_t)item * PREP_ITEM;
        bf16_t* wp = (bf16_t*)(pi + PI_W); bf16_t* qgp = (bf16_t*)(pi + PI_QG); bf16_t* kdTp = (bf16_t*)(pi + PI_KD); bf16_t* uT = (bf16_t*)(pi + PI_UT); bf16_t* aqkp = (bf16_t*)(pi + PI_AQ);
        const bf16_t* qbase = qb + r0 * 512 + h * 128; const bf16_t* kbase = kb + r0 * 512 + h * 128;
        const bf16_t* kTb = kT + ((size_t)bn * 512 + h * 128) * 64; const bf16_t* vTb = vT + ((size_t)bn * 512 + h * 128) * 64;
        bf16x8 ak[4], aq[4], bkf[2][4];
#pragma unroll
        for (int s = 0; s < 4; ++s) { ak[s] = *(const bf16x8*)(kbase + (size_t)(16 * lw + r) * 512 + 32 * s + 8 * q); aq[s] = *(const bf16x8*)(qbase + (size_t)(16 * lw + r) * 512 + 32 * s + 8 * q); }
#pragma unroll
        for (int tj = 0; tj < 2; ++tj)
#pragma unroll
            for (int s = 0; s < 4; ++s) bkf[tj][s] = *(const bf16x8*)(kbase + (size_t)(16 * tj + r) * 512 + 32 * s + 8 * q);
        bf16x8 pv[2][2], pk[2][2];
        if (role != 0) {
#pragma unroll
        for (int cc = 0; cc < 2; ++cc) { const int ct = 2 * lw + cc;
            pv[cc][0] = *(const bf16x8*)(vTb + (size_t)(16 * ct + r) * 64 + 8 * q); pv[cc][1] = *(const bf16x8*)(vTb + (size_t)(16 * ct + r) * 64 + 32 + 8 * q);
            pk[cc][0] = *(const bf16x8*)(kTb + (size_t)(16 * ct + r) * 64 + 8 * q); pk[cc][1] = *(const bf16x8*)(kTb + (size_t)(16 * ct + r) * 64 + 32 + 8 * q); } }
        float gv = gB[(r0 + lane) * 4 + h];
#pragma unroll
        for (int off = 1; off < 64; off <<= 1) { const float t = __shfl_up(gv, off); if (lane >= off) gv += t; }
        const float g63 = __shfl(gv, 63);
        if (lw == 0) { sG[lane] = gv; sB[lane] = betaB[(r0 + lane) * 4 + h]; sE[lane] = __expf(gv); sK[lane] = __expf(g63 - gv); }
        if ((tid & 255) == 0) glast[item] = __expf(g63);
        __syncthreads();
        {
#pragma unroll
            for (int tj = 0; tj < 4; ++tj) {
                f32x4 ckk = {0.f, 0.f, 0.f, 0.f}, cqk = {0.f, 0.f, 0.f, 0.f};
#pragma unroll
                for (int s = 0; s < 4; ++s) { const bf16x8 bk = (tj < 2) ? bkf[tj & 1][s] : *(const bf16x8*)(kbase + (size_t)(16 * tj + r) * 512 + 32 * s + 8 * q); ckk = MFMA16(ak[s], bk, ckk); cqk = MFMA16(aq[s], bk, cqk); }
                const int j = 16 * tj + r; const float Gj = sG[j]; const int jpos = (j & 32) + perm32s(j & 31);
                f32x4 lv;
#pragma unroll
                for (int e = 0; e < 4; ++e) { const int i = 16 * lw + 4 * q + e; const float Gi = sG[i], bi = sB[i];
                    const float dec = (i >= j) ? __expf(Gi - Gj) : 0.f;
                    lv[e] = (i > j) ? ckk[e] * bi * dec : 0.f;
                    aqkp[i * 64 + jpos] = f2bf((i >= j) ? cqk[e] * dec : 0.f); }
                *(PG8_LAS f32x4*)(sL + j * 64 + 16 * lw + 4 * q) = lv;
            }
        }
        __syncthreads();
        if (role == 0) {
            float x[64];
#pragma unroll
            for (int i = 0; i < 64; ++i) x[i] = (i == lane) ? 1.0f : 0.0f;
            __builtin_amdgcn_s_setprio(3);
            solve64(x, sL);
            __builtin_amdgcn_s_setprio(0);
#pragma unroll
            for (int cc = 0; cc < 2; ++cc) { const int ct = 2 * lw + cc;
                pv[cc][0] = *(const bf16x8*)(vTb + (size_t)(16 * ct + r) * 64 + 8 * q); pv[cc][1] = *(const bf16x8*)(vTb + (size_t)(16 * ct + r) * 64 + 32 + 8 * q);
                pk[cc][0] = *(const bf16x8*)(kTb + (size_t)(16 * ct + r) * 64 + 8 * q); pk[cc][1] = *(const bf16x8*)(kTb + (size_t)(16 * ct + r) * 64 + 32 + 8 * q); }
            const float bj = sB[lane], bej = bj * sE[lane];
#pragma unroll
            for (int i = 0; i < 64; ++i) { *(PG8_LAS bf16_t*)(Tu + (i * 72 + lane) * 2) = f2bf(x[i] * bj); *(PG8_LAS bf16_t*)(Tw + (i * 72 + lane) * 2) = f2bf(x[i] * bej); }
        } else if (role == 1) {
#pragma unroll 4
            for (int k = 0; k < 16; ++k) { const int pidx = lane + 64 * k, i = pidx >> 4, pc = pidx & 15, aa = pc & 3, c32 = (pc >> 2) * 32;
                float f[8]; unpack8(*(const u32x4*)(qbase + (size_t)i * 512 + pc * 8), f); const float e = sE[i];
                u32x2 lo, hi; lo.x = pk2(f[0] * e, f[1] * e); lo.y = pk2(f[2] * e, f[3] * e); hi.x = pk2(f[4] * e, f[5] * e); hi.y = pk2(f[6] * e, f[7] * e);
                *(u32x2*)(qgp + i * 128 + c32 + 8 * ((2 * aa) & 3) + 4 * (aa >> 1)) = lo;
                *(u32x2*)(qgp + i * 128 + c32 + 8 * ((2 * aa + 1) & 3) + 4 * (aa >> 1)) = hi; }
        } else {
            const int d = (role - 2) * 64 + lane; float x[64];
#pragma unroll
            for (int c8 = 0; c8 < 8; ++c8) { float f[8]; unpack8(*(const u32x4*)(kTb + (size_t)d * 64 + 8 * c8), f);
#pragma unroll
                for (int e = 0; e < 8; ++e) x[8 * c8 + e] = f[e] * sK[8 * c8 + e]; }
#pragma unroll
            for (int c8 = 0; c8 < 8; ++c8) { u32x4 o;
                o.x = pk2(x[tokofpos(8 * c8 + 0)], x[tokofpos(8 * c8 + 1)]); o.y = pk2(x[tokofpos(8 * c8 + 2)], x[tokofpos(8 * c8 + 3)]);
                o.z = pk2(x[tokofpos(8 * c8 + 4)], x[tokofpos(8 * c8 + 5)]); o.w = pk2(x[tokofpos(8 * c8 + 6)], x[tokofpos(8 * c8 + 7)]);
                *(u32x4*)(kdTp + d * 64 + 8 * c8) = o; }
        }
        __syncthreads();
        {
            bf16x8 tf[4][2];
#pragma unroll
            for (int it = 0; it < 4; ++it)
#pragma unroll
                for (int s = 0; s < 2; ++s) tf[it][s] = *(const PG8_LAS bf16x8*)(Tu + ((16 * it + r) * 72 + 32 * s + 8 * q) * 2);
#pragma unroll
            for (int cc = 0; cc < 2; ++cc) { const int ct = 2 * lw + cc;
                const bf16x8 v0 = pv[cc][0], v1 = pv[cc][1];
#pragma unroll
                for (int it = 0; it < 4; ++it) { f32x4 acc = {0.f, 0.f, 0.f, 0.f}; acc = MFMA16(tf[it][0], v0, acc); acc = MFMA16(tf[it][1], v1, acc);
                    u32x2 w; w.x = pk2c(acc[0], acc[1]); w.y = pk2c(acc[2], acc[3]);
                    *(u32x2*)(uT + (16 * ct + r) * 64 + 16 * it + 4 * q) = w; } }
#pragma unroll
            for (int it = 0; it < 4; ++it)
#pragma unroll
                for (int s = 0; s < 2; ++s) tf[it][s] = *(const PG8_LAS bf16x8*)(Tw + ((16 * it + r) * 72 + 32 * s + 8 * q) * 2);
#pragma unroll
            for (int cc = 0; cc < 2; ++cc) { const int dt = 2 * lw + cc;
                const bf16x8 k0 = pk[cc][0], k1 = pk[cc][1];
                const int o4 = 16 * dt + 4 * q, dpos = (o4 & ~31) + perm32s(o4 & 31);
#pragma unroll
                for (int it = 0; it < 4; ++it) { f32x4 acc = {0.f, 0.f, 0.f, 0.f}; acc = MFMA16(k0, tf[it][0], acc); acc = MFMA16(k1, tf[it][1], acc);
                    u32x2 w; w.x = pk2c(acc[0], acc[1]); w.y = pk2c(acc[2], acc[3]);
                    *(u32x2*)(wp + (16 * it + r) * 128 + dpos) = w; } }
        }
        __syncthreads();
    }
}

__device__ __forceinline__ void phase_scan(const Args& a, PG8_LAS unsigned char* lds, int sblk) {
    const int tid = threadIdx.x, lane = tid & 63, wave = tid >> 6, q = lane >> 4, r = lane & 15;
    const int bh = sblk >> 1, dvh = sblk & 1, b = bh >> 2, h = bh & 3;
    bf16_t* of = (bf16_t*)(a.ws + WS_OF2); const float* glast = (const float*)(a.ws + WS_GL);
    constexpr int L_W = 0, L_QG = 17408, L_KD = 34816, L_UT = 53248, L_AQ = 71680;
    f32x4 S[8];
#pragma unroll
    for (int m = 0; m < 8; ++m) S[m] = (f32x4){0.f, 0.f, 0.f, 0.f};
    u32x4 pre[9];
    { const unsigned char* src = a.ws + WS_PREP + (size_t)((b * 32 + 0) * 4 + h) * PREP_ITEM;
#pragma unroll
      for (int i = 0; i < 9; ++i) pre[i] = __builtin_nontemporal_load((const u32x4*)(src + (size_t)(tid + 512 * i) * 16)); }
    for (int n = 0; n < 32; ++n) {
#pragma unroll
        for (int i = 0; i < 9; ++i) { const int p = tid + 512 * i; int off;
            if (i < 2) off = L_W + (p >> 4) * 272 + (p & 15) * 16;
            else if (i < 4) { const int pp = p - 1024; off = L_QG + (pp >> 4) * 272 + (pp & 15) * 16; }
            else if (i < 6) { const int pp = p - 2048; off = L_KD + (pp >> 3) * 144 + (pp & 7) * 16; }
            else if (i < 8) { const int pp = p - 3072; off = L_UT + (pp >> 3) * 144 + (pp & 7) * 16; }
            else { const int pp = p - 4096; off = L_AQ + (pp >> 3) * 144 + (pp & 7) * 16; }
            *(PG8_LAS u32x4*)(lds + off) = pre[i]; }
        __syncthreads();
        if (n + 1 < 32) { const unsigned char* src = a.ws + WS_PREP + (size_t)((b * 32 + n + 1) * 4 + h) * PREP_ITEM;
#pragma unroll
            for (int i = 0; i < 9; ++i) pre[i] = __builtin_nontemporal_load((const u32x4*)(src + (size_t)(tid + 512 * i) * 16)); }
        if (wave < 4) {
            __builtin_amdgcn_s_setprio(2);
            const int dv0 = dvh * 64 + wave * 16; const float gl = glast[(b * 32 + n) * 4 + h]; const size_t row0 = (size_t)b * 2048 + n * 64;
            bf16x8 Sb[4];
#pragma unroll
            for (int s = 0; s < 4; ++s) Sb[s] = packf8(S[2 * s], S[2 * s + 1]);
            f32x4 vn[4];
#pragma unroll
            for (int mt = 0; mt < 4; ++mt) {
                const u32x2 uu = *(const PG8_LAS u32x2*)(lds + L_UT + (dv0 + r) * 144 + (16 * mt + 4 * q) * 2);
                f32x4 acc = {0.f, 0.f, 0.f, 0.f};
#pragma unroll
                for (int s = 0; s < 4; ++s) { const bf16x8 af = *(const PG8_LAS bf16x8*)(lds + L_W + (16 * mt + r) * 272 + (32 * s + 8 * q) * 2); acc = MFMA16(af, Sb[s], acc); }
                vn[mt] = (f32x4){bf_lo(uu.x), bf_hi(uu.x), bf_lo(uu.y), bf_hi(uu.y)} - acc;
            }
            bf16x8 Vb[2];
#pragma unroll
            for (int s = 0; s < 2; ++s) Vb[s] = packf8(vn[2 * s], vn[2 * s + 1]);
#pragma unroll
            for (int mt = 0; mt < 4; ++mt) {
                f32x4 o = {0.f, 0.f, 0.f, 0.f};
#pragma unroll
                for (int s = 0; s < 4; ++s) { const bf16x8 af = *(const PG8_LAS bf16x8*)(lds + L_QG + (16 * mt + r) * 272 + (32 * s + 8 * q) * 2); o = MFMA16(af, Sb[s], o); }
#pragma unroll
                for (int s = 0; s < 2; ++s) { const bf16x8 af = *(const PG8_LAS bf16x8*)(lds + L_AQ + (16 * mt + r) * 144 + (32 * s + 8 * q) * 2); o = MFMA16(af, Vb[s], o); }
#pragma unroll
                for (int e = 0; e < 4; ++e) of[(row0 + 16 * mt + 4 * q + e) * 512 + h * 128 + dv0 + r] = (bf16_t)(pk2c(o[e], o[e]) & 0xffffu);
            }
#pragma unroll
            for (int mt = 0; mt < 8; ++mt) {
                f32x4 acc = S[mt] * gl;
#pragma unroll
                for (int s = 0; s < 2; ++s) { const bf16x8 af = *(const PG8_LAS bf16x8*)(lds + L_KD + (16 * mt + r) * 144 + (32 * s + 8 * q) * 2); acc = MFMA16(af, Vb[s], acc); }
                S[mt] = acc;
            }
            __builtin_amdgcn_s_setprio(0);
        }
        __syncthreads();
    }
}
template <int WIN>
__device__ __forceinline__ void pool_loop(const Args& a, PG8_LAS unsigned char* lds, int bid, int nb, int gi) {
    const int tid = threadIdx.x, lane = tid & 63, wave = tid >> 6, q = lane >> 4, r = lane & 15;
    const bf16_t* proj = (const bf16_t*)(a.ws + WS_PROJ); bf16_t* mix = (bf16_t*)(a.ws + WS_MIX);
    constexpr int L_WT = 34816, L_PB = L_WT + 128 * 272, NR = WIN + 3;
    const int pc = tid & 15, tr = tid >> 4, tok0 = 4 * tr;
    const bf16_t* base = proj + 2048 + gi * 128 + pc * 8;
    int item = bid; if (item >= 1024) return;
    u32x4 R[NR];
    { const int rowA = (item >> 2) * 128 + tok0, pos0 = rowA & 2047;
#pragma unroll
      for (int j = 0; j < NR; ++j) { const int dr = j - (WIN - 1); const int rr = (pos0 + dr >= 0) ? rowA + dr : rowA; R[j] = *(const u32x4*)(base + (size_t)rr * NPROJ); } }
    for (; item < 1024; item += nb) {
        const int row0 = (item >> 2) * 128, rowA = row0 + tok0, pos0 = rowA & 2047;
        {
            float s[8];
#pragma unroll
            for (int e = 0; e < 8; ++e) s[e] = 0.f;
#pragma unroll
            for (int j = 0; j < WIN; ++j) { float f[8]; unpack8(R[j], f); const float vm = (pos0 + j - (WIN - 1) >= 0) ? 1.0f : 0.0f;
#pragma unroll
                for (int e = 0; e < 8; ++e) s[e] += vm * f[e]; }
#pragma unroll
            for (int m = 0; m < 4; ++m) {
                float u[8]; unpack8(R[WIN - 1 + m], u);
                if (m > 0) { float o[8]; unpack8(R[m - 1], o); const float vm = (pos0 + m - WIN >= 0) ? 1.0f : 0.0f;
#pragma unroll
                    for (int e = 0; e < 8; ++e) s[e] += u[e] - vm * o[e]; }
                const int n = (pos0 + m + 1) < WIN ? (pos0 + m + 1) : WIN; const float inv = 1.0f / (float)n; float d[8];
#pragma unroll
                for (int e = 0; e < 8; ++e) d[e] = s[e] * inv - u[e];
                *(PG8_LAS u32x4*)(lds + (tok0 + m) * 272 + pc * 16) = pack8(d);
            }
        }
        __syncthreads();
        const bool more = item + nb < 1024;
        if (more) { const int rowB = ((item + nb) >> 2) * 128 + tok0, posB = rowB & 2047;
#pragma unroll
            for (int j = 0; j < NR; ++j) { const int dr = j - (WIN - 1); const int rr = (posB + dr >= 0) ? rowB + dr : rowB; R[j] = *(const u32x4*)(base + (size_t)rr * NPROJ); } }
        { bf16x8 df[4];
#pragma unroll
          for (int s = 0; s < 4; ++s) df[s] = *(const PG8_LAS bf16x8*)(lds + (16 * wave + r) * 272 + (32 * s + 8 * q) * 2);
#pragma unroll
          for (int nt = 0; nt < 8; ++nt) { f32x4 acc = {0.f, 0.f, 0.f, 0.f};
#pragma unroll
              for (int s = 0; s < 4; ++s) { const bf16x8 wf = *(const PG8_LAS bf16x8*)(lds + L_WT + (16 * nt + r) * 272 + (32 * s + 8 * q) * 2); acc = MFMA16(wf, df[s], acc); }
              const int dl = 16 * nt + 4 * q; const f32x4 o = (acc + *(const PG8_LAS f32x4*)(lds + L_PB + dl * 4)) * *(const PG8_LAS f32x4*)(lds + L_PB + 512 + dl * 4);
              u32x2 w; w.x = pk2(o[0], o[1]); w.y = pk2(o[2], o[3]);
              *(u32x2*)(mix + (size_t)(row0 + 16 * wave + r) * 1024 + 512 + gi * 128 + dl) = w; } }
        __syncthreads();
    }
}
__device__ __forceinline__ void phase_pool(const Args& a, PG8_LAS unsigned char* lds, int bid, int nb) {
    const int tid = threadIdx.x;
    const bf16_t* pwt = (const bf16_t*)(a.ws + WS_PWT);
    const int gi = bid & 3;
    constexpr int L_WT = 34816, L_PB = L_WT + 128 * 272;
#pragma unroll
    for (int k = 0; k < 4; ++k) { const int idx = tid + 512 * k, row = idx >> 4, pc = idx & 15;
        *(PG8_LAS u32x4*)(lds + L_WT + row * 272 + pc * 16) = *(const u32x4*)(pwt + (size_t)row * 512 + gi * 128 + pc * 8); }
    if (tid < 128) { ((PG8_LAS float*)(lds + L_PB))[tid] = a.in[8][gi * 128 + tid]; ((PG8_LAS float*)(lds + L_PB))[128 + tid] = a.in[9][gi * 128 + tid]; }
    __syncthreads();
    if (gi == 0) pool_loop<2>(a, lds, bid, nb, 0); else if (gi == 1) pool_loop<4>(a, lds, bid, nb, 1); else if (gi == 2) pool_loop<8>(a, lds, bid, nb, 2); else pool_loop<16>(a, lds, bid, nb, 3);
}
__device__ __forceinline__ void phase_gate(const Args& a) {
    const int tid = threadIdx.x, lane = tid & 63, wave = tid >> 6;
    const bf16_t* proj = (const bf16_t*)(a.ws + WS_PROJ); const bf16_t* of = (const bf16_t*)(a.ws + WS_OF2); bf16_t* mix = (bf16_t*)(a.ws + WS_MIX);
    const float* onw = a.in[6]; const int c0 = (8 * lane) & 127;
    const f32x4 w0 = *(const f32x4*)(onw + c0), w1 = *(const f32x4*)(onw + c0 + 4);
    for (int row = blockIdx.x * 8 + wave; row < M; row += gridDim.x * 8) {
        float of8[8]; unpack8(*(const u32x4*)(of + (size_t)row * 512 + 8 * lane), of8);
        const f32x4 o0 = {of8[0], of8[1], of8[2], of8[3]}, o1 = {of8[4], of8[5], of8[6], of8[7]};
        float ss = (o0[0] * o0[0] + o0[1] * o0[1]) + (o0[2] * o0[2] + o0[3] * o0[3]) + (o1[0] * o1[0] + o1[1] * o1[1]) + (o1[2] * o1[2] + o1[3] * o1[3]);
        ss = sum16(ss); const float r = rsqrtf(ss * (1.0f / 128.0f) + EPS);
        float z[8]; unpack8(*(const u32x4*)(proj + (size_t)row * NPROJ + 1536 + 8 * lane), z);
        float y[8];
        y[0] = o0[0] * r * w0[0] * siluf_(z[0]); y[1] = o0[1] * r * w0[1] * siluf_(z[1]); y[2] = o0[2] * r * w0[2] * siluf_(z[2]); y[3] = o0[3] * r * w0[3] * siluf_(z[3]);
        y[4] = o1[0] * r * w1[0] * siluf_(z[4]); y[5] = o1[1] * r * w1[1] * siluf_(z[5]); y[6] = o1[2] * r * w1[2] * siluf_(z[6]); y[7] = o1[3] * r * w1[3] * siluf_(z[7]);
        *(u32x4*)(mix + (size_t)row * 1024 + 8 * lane) = pack8(y);
    }
}
__device__ __forceinline__ void phase_ffnconv(const Args& a, int hf) {
    const bf16_t* up = (const bf16_t*)(a.ws + WS_UPH); bf16_t* act = (bf16_t*)(a.ws + WS_ACT);
    const float* fw = a.in[13]; const float* fb = a.in[14];
    const int total = 16384 * 352;
    for (int it = blockIdx.x * NT + threadIdx.x; it < total; it += gridDim.x * NT) {
        const int rl = it / 352, p = it - rl * 352, j0 = p * 8, pn = j0 >> 7, jj = j0 & 127, row = hf * 16384 + rl, t = row & 2047, gcol = 256 * pn + jj;
        float g[8], v[8];
        { const f32x4 b0 = *(const f32x4*)(fb + j0), b1 = *(const f32x4*)(fb + j0 + 4), c0 = *(const f32x4*)(fb + DFF + j0), c1 = *(const f32x4*)(fb + DFF + j0 + 4);
          g[0] = b0[0]; g[1] = b0[1]; g[2] = b0[2]; g[3] = b0[3]; g[4] = b1[0]; g[5] = b1[1]; g[6] = b1[2]; g[7] = b1[3];
          v[0] = c0[0]; v[1] = c0[1]; v[2] = c0[2]; v[3] = c0[3]; v[4] = c1[0]; v[5] = c1[1]; v[6] = c1[2]; v[7] = c1[3]; }
#pragma unroll
        for (int i = 0; i < 3; ++i) { if (t - 2 + i >= 0) {
            float gf[8], vf[8]; unpack8(*(const u32x4*)(up + (size_t)(rl - 2 + i) * NUP + gcol), gf); unpack8(*(const u32x4*)(up + (size_t)(rl - 2 + i) * NUP + gcol + 128), vf);
            const float* wg = fw + (size_t)i * NUP + j0; const float* wv = wg + DFF;
            const f32x4 a0 = *(const f32x4*)wg, a1 = *(const f32x4*)(wg + 4), e0 = *(const f32x4*)wv, e1 = *(const f32x4*)(wv + 4);
            g[0] += gf[0] * a0[0]; g[1] += gf[1] * a0[1]; g[2] += gf[2] * a0[2]; g[3] += gf[3] * a0[3]; g[4] += gf[4] * a1[0]; g[5] += gf[5] * a1[1]; g[6] += gf[6] * a1[2]; g[7] += gf[7] * a1[3];
            v[0] += vf[0] * e0[0]; v[1] += vf[1] * e0[1]; v[2] += vf[2] * e0[2]; v[3] += vf[3] * e0[3]; v[4] += vf[4] * e1[0]; v[5] += vf[5] * e1[1]; v[6] += vf[6] * e1[2]; v[7] += vf[7] * e1[3]; } }
        float o[8];
#pragma unroll
        for (int e = 0; e < 8; ++e) o[e] = siluf_(g[e]) * v[e];
        *(u32x4*)(act + (size_t)row * DFF + j0) = pack8(o);
    }
}
__device__ __forceinline__ void phase_final(const Args& a) {
    const int tid = threadIdx.x, lane = tid & 63, wave = tid >> 6; const float* fw = a.in[16];
    const bf16_t* yb = (const bf16_t*)(a.ws + WS_YB); const float* ss3 = (const float*)(a.ws + WS_SS3);
    f32x4 nwv[4];
#pragma unroll
    for (int j = 0; j < 2; ++j) { nwv[2 * j] = *(const f32x4*)(fw + 512 * j + 8 * lane); nwv[2 * j + 1] = *(const f32x4*)(fw + 512 * j + 8 * lane + 4); }
    for (int row = blockIdx.x * 8 + wave; row < M; row += gridDim.x * 8) {
        const u32x4 y0 = *(const u32x4*)(yb + (size_t)row * 1024 + 8 * lane), y1 = *(const u32x4*)(yb + (size_t)row * 1024 + 512 + 8 * lane);
        const f32x4 s0 = *(const f32x4*)(ss3 + (size_t)row * 16), s1 = *(const f32x4*)(ss3 + (size_t)row * 16 + 4), s2 = *(const f32x4*)(ss3 + (size_t)row * 16 + 8), s3 = *(const f32x4*)(ss3 + (size_t)row * 16 + 12);
        const float ss = ((s0[0] + s0[1]) + (s0[2] + s0[3])) + ((s1[0] + s1[1]) + (s1[2] + s1[3])) + ((s2[0] + s2[1]) + (s2[2] + s2[3])) + ((s3[0] + s3[1]) + (s3[2] + s3[3]));
        const float rstd = rsqrtf(ss * (1.0f / 1024.0f) + EPS);
        float f0[8], f1[8]; unpack8(y0, f0); unpack8(y1, f1);
        float* op = a.out + (size_t)row * 1024 + 8 * lane;
        *(f32x4*)op = (f32x4){f0[0], f0[1], f0[2], f0[3]} * rstd * nwv[0]; *(f32x4*)(op + 4) = (f32x4){f0[4], f0[5], f0[6], f0[7]} * rstd * nwv[1];
        *(f32x4*)(op + 512) = (f32x4){f1[0], f1[1], f1[2], f1[3]} * rstd * nwv[2]; *(f32x4*)(op + 516) = (f32x4){f1[4], f1[5], f1[6], f1[7]} * rstd * nwv[3];
    }
}

#define XB_TMO      128
#define XB_XCNT(j)  (256  + 64 * (j))
#define XB_XSUB(j)  (1280 + 64 * (j))
#define XB_XGEN(j)  (2304 + 64 * (j))
#define XB_TOP      3328
#define XB_TOPGEN   3392
#define XCD_BAR_WORDS 3456
#define XB_SPIN_CAP (1u << 18)
#define LAS __attribute__((address_space(3)))

__device__ __forceinline__ unsigned xb_ld(unsigned* p)              { return __hip_atomic_load(p, __ATOMIC_RELAXED, __HIP_MEMORY_SCOPE_AGENT); }
__device__ __forceinline__ unsigned xb_add(unsigned* p, unsigned v) { return __hip_atomic_fetch_add(p, v, __ATOMIC_RELAXED, __HIP_MEMORY_SCOPE_AGENT); }
__device__ __forceinline__ unsigned xb_xcc_id() { return (unsigned)__builtin_amdgcn_s_getreg((3 << 11) | 20) & 0xFu; }
#define XB_SPIN(cond, bar) do { unsigned _sp = 0; while (cond) { __builtin_amdgcn_s_sleep(1); \
    if ((++_sp & 255u) == 0u) { if (xb_ld(&(bar)[XB_TMO])) break; if (_sp > XB_SPIN_CAP) { atomicAdd(&(bar)[XB_TMO], 1u); break; } } } } while (0)

struct XcdBarrier {
    unsigned* bar; unsigned x;
    volatile LAS unsigned* st;
};

__device__ __forceinline__ XcdBarrier xcd_barrier_post(unsigned* bar, volatile LAS unsigned* st) {
    XcdBarrier b; b.bar = bar; b.x = xb_xcc_id(); b.st = st;
    if (threadIdx.x == 0) (void)xb_add(&bar[XB_XCNT(b.x)], 1u);
    return b;
}
__device__ __forceinline__ void xcd_barrier_complete(unsigned* bar, unsigned x, unsigned& nloc, unsigned& nx) {
    const unsigned G = gridDim.x * gridDim.y * gridDim.z;
    unsigned sum, cnt, mine, sp = 0u;
    for (;;) {
        sum = 0u; cnt = 0u; mine = 0u;
#pragma unroll
        for (unsigned j = 0; j < 16; ++j) { const unsigned c = xb_ld(&bar[XB_XCNT(j)]); sum += c; cnt += (c > 0u) ? 1u : 0u; mine = (j == x) ? c : mine; }
        if (sum == G) break;
        __builtin_amdgcn_s_sleep(1);
        if ((++sp & 255u) == 0u) { if (xb_ld(&bar[XB_TMO])) break; if (sp > XB_SPIN_CAP) { atomicAdd(&bar[XB_TMO], 1u); break; } }
    }
    nloc = mine > 0u ? mine : 1u; nx = cnt > 0u ? cnt : 1u;
}

__device__ __forceinline__ void xcd_barrier(const XcdBarrier& b) {
    asm volatile("s_waitcnt vmcnt(0)" ::: "memory");
    __syncthreads();
    if (threadIdx.x == 0) {
        unsigned* bar = b.bar;
        __builtin_amdgcn_s_waitcnt(0);
        unsigned nloc = b.st[0], nx = b.st[1];
        if (nloc == 0u) { xcd_barrier_complete(bar, b.x, nloc, nx); b.st[0] = nloc; b.st[1] = nx; }
        const unsigned old = xb_add(&bar[XB_XSUB(b.x)], 1u);
        const unsigned gen = old / nloc;
        if (old + 1u == (gen + 1u) * nloc) {
            __builtin_amdgcn_fence(__ATOMIC_RELEASE, "agent");
            asm volatile("s_waitcnt vmcnt(0)" ::: "memory");
            const unsigned og = xb_add(&bar[XB_TOP], 1u);
            const unsigned tg = og / nx;
            if (og + 1u == (tg + 1u) * nx) xb_add(&bar[XB_TOPGEN], 1u);
            else XB_SPIN(xb_ld(&bar[XB_TOPGEN]) == tg, bar);
            __builtin_amdgcn_fence(__ATOMIC_ACQUIRE, "agent");
            xb_add(&bar[XB_XGEN(b.x)], 1u);
            asm volatile("s_waitcnt vmcnt(0)" ::: "memory");
        } else {
            XB_SPIN(xb_ld(&bar[XB_XGEN(b.x)]) == gen, bar);
            __builtin_amdgcn_fence(__ATOMIC_ACQUIRE, "agent");
            asm volatile("s_waitcnt vmcnt(0)" ::: "memory");
        }
    }
    __syncthreads();
}


__global__ void __launch_bounds__(NT) mega(Args a) {
    extern __shared__ __attribute__((aligned(16))) unsigned char lds_raw[];
    cg::grid_group grid = cg::this_grid();
    PG8_LAS unsigned char* lds = (PG8_LAS unsigned char*)lds_raw;
    volatile LAS unsigned* xst = (volatile LAS unsigned*)(lds + 131072);
    if (threadIdx.x < 4) xst[threadIdx.x] = 0u;
    __syncthreads();
    if (blockIdx.x == 0) { unsigned* bw = (unsigned*)(a.ws + WS_BAR); for (int i = threadIdx.x; i < XCD_BAR_WORDS; i += NT) bw[i] = 0u; }
    bf16_t* WinT = (bf16_t*)(a.ws + WS_WIN); bf16_t* WoutT = (bf16_t*)(a.ws + WS_WOUT); bf16_t* WupT = (bf16_t*)(a.ws + WS_WUP); bf16_t* WdownT = (bf16_t*)(a.ws + WS_WDOWN);
    bf16_t* h1b = (bf16_t*)a.out; bf16_t* proj = (bf16_t*)(a.ws + WS_PROJ); bf16_t* mix = (bf16_t*)(a.ws + WS_MIX); bf16_t* xb = (bf16_t*)(a.ws + WS_XB);
    bf16_t* uph = (bf16_t*)(a.ws + WS_UPH); bf16_t* act = (bf16_t*)(a.ws + WS_ACT); float* ss2 = (float*)(a.ws + WS_SS2);

    const unsigned mk = a.mask;
    if (mk & 1u) { phase_weights(a, (PG8_LAS float*)lds, 0, TW_B, (int)blockIdx.x, (int)gridDim.x); }
    __syncthreads();
    if (mk & 2048u) phase_norm1(a, (float*)lds_raw);
    grid.sync();
    XcdBarrier xbar = xcd_barrier_post((unsigned*)(a.ws + WS_BAR), xst);
    if (mk & 2u)
    { pg8::Gemm g{h1b, WinT, M, NPROJ, D}; pg8::StaticOrder S; S.init(M, NPROJ, (int)gridDim.x, (int)blockIdx.x); EpiBf16Plain E{proj, NPROJ, (const float*)(a.ws + WS_RS1)};
      pg8::gemm_phase<EpiBf16Plain, pg8::StaticOrder, true, true>(lds, g, S, E); }
    xcd_barrier(xbar);
    if (mk & 4u) phase_qkv(a);
    xcd_barrier(xbar);
    if (mk & 8u) phase_prep(a, lds);
    xcd_barrier(xbar);
    if (gridDim.x >= 256) { if (blockIdx.x < 128) { if (mk & 16u) phase_scan(a, lds, (int)blockIdx.x); } else if (mk & 4096u) { phase_pool(a, lds, (int)blockIdx.x - 128, (int)gridDim.x - 128); phase_weights(a, (PG8_LAS float*)lds, TW_B, TW_END, (int)blockIdx.x - 128, (int)gridDim.x - 128); } }
    else { if (mk & 16u) for (int sb = blockIdx.x; sb < 128; sb += gridDim.x) phase_scan(a, lds, sb); if (mk & 4096u) { phase_pool(a, lds, (int)blockIdx.x, (int)gridDim.x & ~3); phase_weights(a, (PG8_LAS float*)lds, TW_B, TW_END, (int)blockIdx.x, (int)gridDim.x); } }
    xcd_barrier(xbar);
    if (mk & 32u) phase_gate(a);
    xcd_barrier(xbar);
    if (mk & 64u)
    { pg8::Gemm g{mix, WoutT, M, D, D}; pg8::StaticOrder S; S.init(M, D, (int)gridDim.x, (int)blockIdx.x); EpiOutProj E{(const bf16_t*)a.out, xb, ss2};
      pg8::gemm_phase<EpiOutProj, pg8::StaticOrder, true, true>(lds, g, S, E); }
    xcd_barrier(xbar);
    if (mk & 128u)
    { pg8::Gemm g{xb, WupT, M, NUP, D}; pg8::StaticOrder S; S.init(M, NUP, (int)gridDim.x, (int)blockIdx.x); EpiUpFused E{act, (bf16_t*)(a.ws + WS_HALO), ss2, a.in[13], a.in[14], lds + 131072 + 256};
      pg8::gemm_phase<EpiUpFused, pg8::StaticOrder, true, true>(lds, g, S, E); }
    xcd_barrier(xbar);
    if (mk & 256u) phase_fixup(a);
    xcd_barrier(xbar);
    if (mk & 512u)
    { pg8::Gemm g{act, WdownT, M, D, DFF}; pg8::StaticOrder S; S.init(M, D, (int)gridDim.x, (int)blockIdx.x); EpiDown E{xb, (bf16_t*)(a.ws + WS_YB), (float*)(a.ws + WS_SS3)};
      pg8::gemm_phase<EpiDown, pg8::StaticOrder, true, true>(lds, g, S, E); }
    xcd_barrier(xbar);
    if (mk & 1024u) phase_final(a);
}

extern "C" void kernel_launch(void* const* d_in, const int* in_sizes, int n_in, void* d_out, int out_size, void* d_ws, size_t ws_size, hipStream_t stream) {
    static int grid_blocks = 0;
    if (!grid_blocks) {
        int dev = 0, cus = 0, per_cu = 0;
        (void)hipGetDevice(&dev);
        (void)hipDeviceGetAttribute(&cus, hipDeviceAttributeMultiprocessorCount, dev);
        (void)hipFuncSetAttribute((const void*)mega, hipFuncAttributeMaxDynamicSharedMemorySize, LDS_BYTES);
        (void)hipOccupancyMaxActiveBlocksPerMultiprocessor(&per_cu, (const void*)mega, NT, LDS_BYTES);
        if (per_cu < 1) { fprintf(stderr, "occupancy query says %d\n", per_cu); per_cu = 1; }
        if (per_cu > 1) per_cu = 1;
        grid_blocks = cus * per_cu;
        if (ws_size < WS_END) fprintf(stderr, "workspace too small: %zu < %zu\n", ws_size, (size_t)WS_END);
    }
    Args a{};
    for (int i = 0; i < 17; ++i) a.in[i] = (const float*)d_in[i];
    a.out = (float*)d_out; a.ws = (unsigned char*)d_ws;
    void* args[] = {&a};
#ifdef PROBE_MASK
    a.mask = PROBE_MASK;
    (void)hipLaunchCooperativeKernel((const void*)mega, dim3(grid_blocks), dim3(NT), args, LDS_BYTES, stream);
#endif
    a.mask = 0x1fffu;
    hipError_t e = hipLaunchCooperativeKernel((const void*)mega, dim3(grid_blocks), dim3(NT), args, LDS_BYTES, stream);
    if (e != hipSuccess) fprintf(stderr, "cooperative launch failed: %s (grid %d)\n", hipGetErrorString(e), grid_blocks);
}
```
